# Optimizing an MI355X kernel written in HIP

```python
import math
import jax, jax.numpy as jnp
from jax import lax
import numpy as np

D_MODEL = 1024
BATCH = 1
SEQ = 16384
DEPTH = 4

HEAD_DIM = 64
N_HEADS = D_MODEL // HEAD_DIM
MOBA_HEADS = N_HEADS // 4
DIL_HEADS = N_HEADS - MOBA_HEADS
SB_HEAD_DIM = 128
SB_HEADS = D_MODEL // SB_HEAD_DIM
MOBA_BLOCK = 256
MOBA_TOPK = 3
DILATED_PAIRS = ((128, 1), (512, 4), (2048, 16))
Q_BLOCK = 128
SB_GROUP_BLOCKS = 8
SB_CUM = 64
FFN_DIM = ((8 * D_MODEL // 3 + 127) // 128) * 128
CONV_WIDTH = 3
ROPE_THETA = 10000.0
LN_EPS = 1e-5
N_EVEN = (DEPTH + 1) // 2
N_ODD = DEPTH // 2
DEEPNORM_ALPHA = (2 * DEPTH) ** 0.25
DEEPNORM_BETA = (8 * DEPTH) ** -0.25

kernel_name = "hybrid_moba_dilated_stickbreak_convffn"


def layer_norm(x, g, b):
    xf = x.astype(jnp.float32)
    mu = jnp.mean(xf, axis=-1, keepdims=True)
    var = jnp.mean(jnp.square(xf - mu), axis=-1, keepdims=True)
    y = (xf - mu) * lax.rsqrt(var + LN_EPS) * g.astype(jnp.float32) + b.astype(jnp.float32)
    return y.astype(x.dtype)


def rope_tables(S):
    inv = 1.0 / (ROPE_THETA ** (jnp.arange(0, HEAD_DIM, 2, dtype=jnp.float32) / HEAD_DIM))
    ang = jnp.arange(S, dtype=jnp.float32)[:, None] * inv[None, :]
    return jnp.cos(ang), jnp.sin(ang)


def apply_rope(x, cos, sin):
    half = HEAD_DIM // 2
    c = cos.astype(x.dtype)
    s = sin.astype(x.dtype)
    x1, x2 = x[..., :half], x[..., half:]
    return jnp.concatenate([x1 * c - x2 * s, x2 * c + x1 * s], axis=-1)


def split_heads(h, w_qkv, n_heads, head_dim):
    B, S, _ = h.shape
    qkv = (h @ w_qkv).reshape(B, S, 3, n_heads, head_dim)
    qkv = qkv.transpose(2, 0, 3, 1, 4)
    return qkv[0], qkv[1], qkv[2]


def merge_heads(o):
    B, H, S, dh = o.shape
    return o.transpose(0, 2, 1, 3).reshape(B, S, H * dh)


def pad_seq(a, Sp):
    S = a.shape[2]
    return jnp.pad(a, ((0, 0), (0, 0), (0, Sp - S), (0, 0)))


def moba_attention(q, k, v):
    B, H, S, dh = q.shape
    Sp = -(-S // MOBA_BLOCK) * MOBA_BLOCK
    q, k, v = pad_seq(q, Sp), pad_seq(k, Sp), pad_seq(v, Sp)
    NB = Sp // MOBA_BLOCK
    kb = k.reshape(B, H, NB, MOBA_BLOCK, dh)
    vb = v.reshape(B, H, NB, MOBA_BLOCK, dh)
    k_sel_count = min(MOBA_TOPK, NB - 1)
    qblk_all = jnp.arange(Sp) // MOBA_BLOCK
    if k_sel_count > 0:
        kmean = jnp.mean(kb.astype(jnp.float32), axis=3).astype(k.dtype)
        gate = jnp.einsum('bhsd,bhnd->bhsn', q, kmean).astype(jnp.float32)
        past = jnp.arange(NB)[None, :] < qblk_all[:, None]
        gate = jnp.where(past, gate, -jnp.inf)
        _, sel = lax.top_k(gate, k_sel_count)
    bi = jnp.arange(B)[:, None, None, None]
    hi = jnp.arange(H)[None, :, None, None]

    def block(c):
        start = c * Q_BLOCK
        qc = lax.dynamic_slice_in_dim(q, start, Q_BLOCK, axis=2)
        pos = start + jnp.arange(Q_BLOCK)
        own = start // MOBA_BLOCK
        k_own = lax.dynamic_index_in_dim(kb, own, axis=2, keepdims=False)
        v_own = lax.dynamic_index_in_dim(vb, own, axis=2, keepdims=False)
        kpos = own * MOBA_BLOCK + jnp.arange(MOBA_BLOCK)
        s_own = jnp.einsum('bhqd,bhkd->bhqk', qc, k_own).astype(jnp.float32)
        s_own = jnp.where(kpos[None, :] <= pos[:, None], s_own, -jnp.inf)
        if k_sel_count == 0:
            p = jax.nn.softmax(s_own, axis=-1)
            return jnp.einsum('bhqk,bhkd->bhqd', p.astype(v.dtype), v_own).astype(q.dtype)
        idx = lax.dynamic_slice_in_dim(sel, start, Q_BLOCK, axis=2)
        k_g = kb[bi, hi, idx]
        v_g = vb[bi, hi, idx]
        s_sel = jnp.einsum('bhqd,bhqnkd->bhqnk', qc, k_g).astype(jnp.float32)
        valid = idx < (pos // MOBA_BLOCK)[None, None, :, None]
        s_sel = jnp.where(valid[..., None], s_sel, -jnp.inf)
        n_sel = k_sel_count * MOBA_BLOCK
        s_all = jnp.concatenate([s_sel.reshape(B, H, Q_BLOCK, n_sel), s_own], axis=-1)
        p = jax.nn.softmax(s_all, axis=-1).astype(v.dtype)
        p_sel = p[..., :n_sel].reshape(B, H, Q_BLOCK, k_sel_count, MOBA_BLOCK)
        o = (jnp.einsum('bhqnk,bhqnkd->bhqd', p_sel, v_g)
             + jnp.einsum('bhqk,bhkd->bhqd', p[..., n_sel:], v_own))
        return o.astype(q.dtype)

    out = lax.map(block, jnp.arange(Sp // Q_BLOCK))
    out = out.transpose(1, 2, 0, 3, 4).reshape(B, H, Sp, dh)
    return out[:, :, :S]


def dilated_branch(q, k, v, window, dil):
    B, H, S, dh = q.shape
    n_back = window // dil
    span = dil * Q_BLOCK
    Sp = -(-S // span) * span
    n_sub = Sp // dil
    nb = n_sub // Q_BLOCK

    def to_sub(a):
        a = pad_seq(a, Sp).reshape(B, H, n_sub, dil, dh).transpose(0, 1, 3, 2, 4)
        return a.reshape(B, H, dil, nb, Q_BLOCK, dh)

    def with_prev(a):
        prev = jnp.pad(a[:, :, :, :-1], ((0, 0), (0, 0), (0, 0), (1, 0), (0, 0), (0, 0)))
        return jnp.concatenate([prev, a], axis=4)

    qs = to_sub(q)
    ks = with_prev(to_sub(k))
    vs = with_prev(to_sub(v))
    s = jnp.einsum('bhrnqd,bhrnkd->bhrnqk', qs, ks).astype(jnp.float32)
    qi = jnp.arange(Q_BLOCK)[:, None]
    kj = jnp.arange(2 * Q_BLOCK)[None, :]
    diff = qi - kj + Q_BLOCK
    nidx = jnp.arange(nb)[:, None, None]
    mask = (diff >= 0) & (diff <= n_back) & ((nidx > 0) | (kj >= Q_BLOCK))
    s = jnp.where(mask, s, -jnp.inf)
    lse = jax.nn.logsumexp(s, axis=-1)
    p = jnp.exp(s - lse[..., None]).astype(v.dtype)
    o = jnp.einsum('bhrnqk,bhrnkd->bhrnqd', p, vs)
    o = o.reshape(B, H, dil, n_sub, dh).transpose(0, 1, 3, 2, 4).reshape(B, H, Sp, dh)[:, :, :S]
    lse = lse.reshape(B, H, dil, n_sub).transpose(0, 1, 3, 2).reshape(B, H, Sp)[:, :, :S]
    return o, lse


def dilated_attention(q, k, v):
    outs, lses = [], []
    for window, dil in DILATED_PAIRS:
        o, l = dilated_branch(q, k, v, window, dil)
        outs.append(o)
        lses.append(l)
    w = jax.nn.softmax(jnp.stack(lses, axis=0), axis=0)
    out = jnp.sum(w[..., None] * jnp.stack(outs, axis=0).astype(jnp.float32), axis=0)
    return out.astype(q.dtype)


def stick_breaking_attention(q, k, v):
    B, H, S, dh = q.shape
    Sp = -(-S // Q_BLOCK) * Q_BLOCK
    q, k, v = pad_seq(q, Sp), pad_seq(k, Sp), pad_seq(v, Sp)
    n_blk = Sp // Q_BLOCK
    ar = jnp.arange(SB_CUM)
    upper = (ar[None, :] >= ar[:, None]).astype(jnp.float32)
    outs = []
    for g0 in range(0, n_blk, SB_GROUP_BLOCKS):
        nb = min(SB_GROUP_BLOCKS, n_blk - g0)
        L = (g0 + nb) * Q_BLOCK
        kg, vg = k[:, :, :L], v[:, :, :L]
        qg = q[:, :, g0 * Q_BLOCK:L]
        kpos = jnp.arange(L)

        def block(c, qg=qg, kg=kg, vg=vg, kpos=kpos, g0=g0, L=L):
            qc = lax.dynamic_slice_in_dim(qg, c * Q_BLOCK, Q_BLOCK, axis=2)
            t = (g0 + c) * Q_BLOCK + jnp.arange(Q_BLOCK)
            z = jnp.einsum('bhqd,bhsd->bhqs', qc, kg).astype(jnp.float32)
            z = jnp.where(kpos[None, :] < t[:, None], z, -jnp.inf)
            sp = jnp.maximum(z, 0.0) + jnp.log1p(jnp.exp(-jnp.abs(z)))
            spb = sp.reshape(B, H, Q_BLOCK, L // SB_CUM, SB_CUM)
            r_in = jnp.einsum('bhqnk,jk->bhqnj', spb, upper)
            tot = r_in[..., 0]
            off = lax.cumsum(tot, axis=3, reverse=True) - tot
            r = (r_in + off[..., None]).reshape(B, H, Q_BLOCK, L)
            a = jnp.exp(z - r).astype(vg.dtype)
            return jnp.einsum('bhqs,bhsd->bhqd', a, vg).astype(q.dtype)

        outs.append(lax.map(block, jnp.arange(nb)))
    out = jnp.concatenate(outs, axis=0).transpose(1, 2, 0, 3, 4).reshape(B, H, Sp, dh)
    return out[:, :, :S]


def even_mixer(h, w_qkv, w_o, cos, sin):
    q, k, v = split_heads(h, w_qkv, N_HEADS, HEAD_DIM)
    q = apply_rope(q, cos, sin) * (HEAD_DIM ** -0.5)
    k = apply_rope(k, cos, sin)
    oa = moba_attention(q[:, :MOBA_HEADS], k[:, :MOBA_HEADS], v[:, :MOBA_HEADS])
    ob = dilated_attention(q[:, MOBA_HEADS:], k[:, MOBA_HEADS:], v[:, MOBA_HEADS:])
    o = jnp.concatenate([oa, ob], axis=1)
    return merge_heads(o) @ w_o


def odd_mixer(h, w_qkv, w_o):
    q, k, v = split_heads(h, w_qkv, SB_HEADS, SB_HEAD_DIM)
    o = stick_breaking_attention(q * (SB_HEAD_DIM ** -0.5), k, v)
    return merge_heads(o) @ w_o


def conv_ffn(h, w_up, conv_w, conv_b, w_down):
    S = h.shape[1]
    u = h @ w_up
    up = jnp.pad(u, ((0, 0), (CONV_WIDTH - 1, 0), (0, 0)))
    c = conv_b
    for j in range(CONV_WIDTH):
        c = c + conv_w[j] * up[:, j:j + S]
    g, val = c[..., :FFN_DIM], c[..., FFN_DIM:]
    return (jax.nn.silu(g) * val) @ w_down


def setup_inputs(seed: int = 0) -> dict:
    key = jax.random.key(seed)
    ks = jax.random.split(key, 20)
    D, F = D_MODEL, FFN_DIM
    sd = D ** -0.5

    def qkv_weight(k0, n):
        a, b, c = jax.random.split(k0, 3)
        wq = jax.random.normal(a, (n, D, D), jnp.float32) * sd
        wk = jax.random.normal(b, (n, D, D), jnp.float32) * sd
        wv = jax.random.normal(c, (n, D, D), jnp.float32) * sd * DEEPNORM_BETA
        return jnp.concatenate([wq, wk, wv], axis=-1)

    return {
        "x": jax.random.normal(ks[0], (BATCH, SEQ, D), jnp.float32),
        "w_qkv_ab": qkv_weight(ks[1], N_EVEN),
        "w_o_ab": jax.random.normal(ks[2], (N_EVEN, D, D), jnp.float32) * sd * DEEPNORM_BETA,
        "w_qkv_c": qkv_weight(ks[3], N_ODD),
        "w_o_c": jax.random.normal(ks[4], (N_ODD, D, D), jnp.float32) * sd * DEEPNORM_BETA,
        "ln_mix_g": 1.0 + 0.02 * jax.random.normal(ks[5], (DEPTH, D), jnp.float32),
        "ln_mix_b": 0.02 * jax.random.normal(ks[6], (DEPTH, D), jnp.float32),
        "w_up": jax.random.normal(ks[7], (DEPTH, D, 2 * F), jnp.float32) * sd * DEEPNORM_BETA,
        "conv_w": jax.random.normal(ks[8], (DEPTH, CONV_WIDTH, 2 * F), jnp.float32) * CONV_WIDTH ** -0.5,
        "conv_b": 0.01 * jax.random.normal(ks[9], (DEPTH, 2 * F), jnp.float32),
        "w_down": jax.random.normal(ks[10], (DEPTH, F, D), jnp.float32) * F ** -0.5 * DEEPNORM_BETA,
        "ln_ffn_g": 1.0 + 0.02 * jax.random.normal(ks[11], (DEPTH, D), jnp.float32),
        "ln_ffn_b": 0.02 * jax.random.normal(ks[12], (DEPTH, D), jnp.float32),
    }


def reference(x, w_qkv_ab, w_o_ab, w_qkv_c, w_o_c, ln_mix_g, ln_mix_b,
              w_up, conv_w, conv_b, w_down, ln_ffn_g, ln_ffn_b):
    cos, sin = rope_tables(x.shape[1])
    for i in range(DEPTH):
        if i % 2 == 0:
            m = even_mixer(x, w_qkv_ab[i // 2], w_o_ab[i // 2], cos, sin)
        else:
            m = odd_mixer(x, w_qkv_c[i // 2], w_o_c[i // 2])
        x = layer_norm(DEEPNORM_ALPHA * x + m.astype(x.dtype), ln_mix_g[i], ln_mix_b[i])
        f = conv_ffn(x, w_up[i], conv_w[i], conv_b[i], w_down[i])
        x = layer_norm(DEEPNORM_ALPHA * x + f.astype(x.dtype), ln_ffn_g[i], ln_ffn_b[i])
    return x
```

```cpp
#include <hip/hip_runtime.h>
#include <hip/hip_cooperative_groups.h>
#include <cstdio>
#include <cstdint>
namespace cg = cooperative_groups;
#include <cmath>
namespace pg8 {
#define PG8_LAS __attribute__((address_space(3)))
typedef unsigned short bf16_t;
typedef short bf16x8 __attribute__((ext_vector_type(8)));
typedef float f32x4 __attribute__((ext_vector_type(4)));
typedef unsigned u32x4 __attribute__((ext_vector_type(4)));
constexpr int BM = 256, BK = 64, HALF = 128, HTB = HALF * BK * 2  , STAGE_BYTES = 8 * HTB, NXCD = 8, WGM = 8;

__host__ __device__ __forceinline__ int lds_byte(int r, int c) { const int st = (r >> 4) * 2 + (c >> 5), rr = r & 15, cc = c & 31, ob = rr * 64 + cc * 2; return st * 1024 + (ob ^ (((ob >> 9) & 1) << 5)); }
__host__ __device__ __forceinline__ void stage_rc(int b, int& R, int& C) { const int st = b / 1024, sb = b % 1024, swz = sb ^ (((sb >> 9) & 1) << 5); R = (st >> 1) * 16 + swz / 64; C = (st & 1) * 32 + (swz % 64) / 2; }
__host__ __device__ __forceinline__ int perm32(int rho) { const int n = rho >> 4, i = rho & 15; return 8 * (i >> 2) + 4 * n + (i & 3); }

struct Unit { int pm, pn; };
struct Gemm { const bf16_t* A; const bf16_t* Bt; int M, N, K; };

struct StaticOrder {
    int nM, nN, nwg, G, c;
    __host__ __device__ void init(int M, int N, int G_, int c_) { nM = M / BM; nN = N / BM; nwg = nM * nN; G = G_; c = c_; }
    __host__ __device__ bool next(int i, Unit& u) const {
        const long L = (long)i * G + c; if (L >= nwg) return false;
        int wgid = (int)L; { const int q = nwg / NXCD, r = nwg % NXCD, xcd = wgid % NXCD, off = wgid / NXCD; wgid = (xcd < r ? xcd * (q + 1) : r * (q + 1) + (xcd - r) * q) + off; }
        const int nig = WGM * nN, gid = wgid / nig, fm = gid * WGM, gsz = (nM - fm) < WGM ? (nM - fm) : WGM;
        u.pm = fm + ((wgid % nig) % gsz); u.pn = (wgid % nig) / gsz; return true;
    }
    __device__ __forceinline__ void a_ready(const Unit&) const {}
    __device__ __forceinline__ void done(const Unit&) const {}
};

__device__ __forceinline__ unsigned cvt_pk_bf16(float lo, float hi) { unsigned r; asm volatile("v_cvt_pk_bf16_f32 %0, %1, %2" : "=v"(r) : "v"(lo), "v"(hi)); return r; }
typedef float f32x2 __attribute__((ext_vector_type(2)));
__device__ __forceinline__ f32x2 gelu_pk(f32x2 v) {
    const f32x2 av = __builtin_elementwise_abs(v), d = av * 0.2316418882f + 1.0f;
    f32x2 t; t.x = __builtin_amdgcn_rcpf(d.x); t.y = __builtin_amdgcn_rcpf(d.y);
    f32x2 q = t * 0.5307027145f + (-0.7265760135f); q = q * t + 0.7107068705f; q = q * t + (-0.142248368f); q = q * t + 0.127414796f; q = q * t;
    const f32x2 s = (v * v) * (-0.72134752044f);
    f32x2 e; e.x = __builtin_amdgcn_exp2f(s.x); e.y = __builtin_amdgcn_exp2f(s.y);
    const f32x2 m = v * (q * e), r = v - m;
    f32x2 o; o.x = v.x < 0.f ? m.x : r.x; o.y = v.y < 0.f ? m.y : r.y; return o;
}

template <int ACT  > struct EpiBf16 {
    static constexpr bool PERM = true, AFTER_DRAIN = false; static_assert(ACT == 0 || ACT == 1, "EpiBf16: ACT is 0 (none) or 1 (gelu_pk)");
    bf16_t* O; int ldc; const float* bias; int split_cols; size_t split_stride; float scale0;
    __device__ __forceinline__ void operator()(const f32x4 (&acc)[2][2][4][2], const Unit& u, int wr, int wc, int fr, int fq) const {
        const int row0 = u.pm * BM + wr * 64 + fr; int colt = u.pn * BM; bf16_t* base = O;
        float sc = 1.f; if (split_cols) { const int t = colt / split_cols; base += (size_t)t * split_stride; colt -= t * split_cols; if (t == 0) sc = scale0; }
        const int col0 = colt + wc * 32 + 8 * fq, bcol0 = u.pn * BM + wc * 32 + 8 * fq;
        f32x4 bv[2][2];
#pragma unroll
        for (int bj = 0; bj < 2; ++bj)
#pragma unroll
            for (int n = 0; n < 2; ++n) bv[bj][n] = bias ? *(const f32x4*)(bias + bcol0 + bj * HALF + 4 * n) : (f32x4){0.f, 0.f, 0.f, 0.f};
#pragma unroll
        for (int ai = 0; ai < 2; ++ai)
#pragma unroll
            for (int m = 0; m < 4; ++m) { bf16_t* rowp = base + (size_t)(row0 + ai * HALF + m * 16) * ldc + col0;
#pragma unroll
                for (int bj = 0; bj < 2; ++bj) { f32x4 v0 = acc[ai][bj][m][0] + bv[bj][0], v1 = acc[ai][bj][m][1] + bv[bj][1];
                    if (ACT == 1) { f32x2 a = gelu_pk((f32x2){v0[0], v0[1]}), b = gelu_pk((f32x2){v0[2], v0[3]}), c = gelu_pk((f32x2){v1[0], v1[1]}), d = gelu_pk((f32x2){v1[2], v1[3]});
                        v0 = (f32x4){a.x, a.y, b.x, b.y}; v1 = (f32x4){c.x, c.y, d.x, d.y}; }
                    v0 = v0 * sc; v1 = v1 * sc; u32x4 w; w.x = cvt_pk_bf16(v0[0], v0[1]); w.y = cvt_pk_bf16(v0[2], v0[3]); w.z = cvt_pk_bf16(v1[0], v1[1]); w.w = cvt_pk_bf16(v1[2], v1[3]);
                    *(u32x4*)(rowp + bj * HALF) = w; } }
    }
};

struct PanelStats {
    unsigned* xbuf;
    unsigned* cnt;
    unsigned* tmo;
    int ntn; float eps;
    unsigned code;
    __device__ __forceinline__ bool run(const f32x4 (&v)[2][2][4][2], const Unit& u, int wr, int wc, int fr, int fq, PG8_LAS unsigned char* lds, int wid, int lane) const {
        typedef float f32x2v __attribute__((ext_vector_type(2)));
        PG8_LAS f32x2v* P = (PG8_LAS f32x2v*)lds;
        PG8_LAS f32x2v* S = (PG8_LAS f32x2v*)(lds + 8192);
        PG8_LAS unsigned* flag = (PG8_LAS unsigned*)(lds + 8192 + 2048);
#pragma unroll
        for (int ai = 0; ai < 2; ++ai)
#pragma unroll
            for (int m = 0; m < 4; ++m) {
                float s = 0.f;
#pragma unroll
                for (int bj = 0; bj < 2; ++bj)
#pragma unroll
                    for (int n = 0; n < 2; ++n) { const f32x4 x = v[ai][bj][m][n]; s += (x[0] + x[1]) + (x[2] + x[3]); }
                s += __shfl_xor(s, 16); s += __shfl_xor(s, 32);
                const float mw = s * (1.0f / 64.0f); float q = 0.f;
#pragma unroll
                for (int bj = 0; bj < 2; ++bj)
#pragma unroll
                    for (int n = 0; n < 2; ++n) { const f32x4 d = v[ai][bj][m][n] - mw; q += (d[0] * d[0] + d[1] * d[1]) + (d[2] * d[2] + d[3] * d[3]); }
                q += __shfl_xor(q, 16); q += __shfl_xor(q, 32);
                if (fq == 0) P[(ai * HALF + wr * 64 + m * 16 + fr) * 4 + wc] = (f32x2v){mw, q};
            }
        asm volatile("s_waitcnt lgkmcnt(0)" ::: "memory"); __builtin_amdgcn_s_barrier(); asm volatile("" ::: "memory");
#if defined(BROKEN_EXCHANGE_NO_WAIT)
#warning BROKEN CONTROL BUILD: the row-statistics exchange does not wait; results are wrong by design
        if (blockIdx.x >= 64) { const long long t0_ = clock64(); while (clock64() - t0_ < 60000) __builtin_amdgcn_s_sleep(8); }
#endif
        const int row = wid * 32 + (lane & 31);
        if (lane < 32) {
            const f32x2v a = P[row * 4 + 0], b = P[row * 4 + 1], c = P[row * 4 + 2], d = P[row * 4 + 3];
            const float mt = (a.x + b.x + c.x + d.x) * 0.25f;
            const float da = a.x - mt, db = b.x - mt, dc = c.x - mt, dd = d.x - mt;
            const float m2 = (a.y + b.y) + (c.y + d.y) + 64.0f * ((da * da + db * db) + (dc * dc + dd * dd));
            unsigned long long* slot = (unsigned long long*)xbuf + ((size_t)(u.pm * BM + row) * 4 + u.pn);
            __hip_atomic_store(slot, ((unsigned long long)__float_as_uint(m2) << 32) | __float_as_uint(mt), __ATOMIC_RELAXED, __HIP_MEMORY_SCOPE_AGENT);
        }
        asm volatile("s_waitcnt vmcnt(0)" ::: "memory");
        if (lane == 0) __hip_atomic_fetch_add(cnt + 64 * u.pm, 1u, __ATOMIC_RELAXED, __HIP_MEMORY_SCOPE_AGENT);
        if (wid == 0) {
            bool dead = false; const unsigned long long t0 = __builtin_amdgcn_s_memrealtime(); const unsigned want = 8u * (unsigned)ntn;
            for (;;) {
#if defined(BROKEN_EXCHANGE_NO_WAIT)
                break;
#endif
                if ((unsigned)__builtin_amdgcn_readfirstlane(__hip_atomic_load(cnt + 64 * u.pm, __ATOMIC_RELAXED, __HIP_MEMORY_SCOPE_AGENT)) >= want) break;
                if (__builtin_amdgcn_s_memrealtime() - t0 > 2000000ull) {
                    if (lane == 0) { unsigned expect = 0u; __hip_atomic_compare_exchange_strong(tmo + 1, &expect, code | (unsigned)(u.pm & 0xff), __ATOMIC_RELAXED, __ATOMIC_RELAXED, __HIP_MEMORY_SCOPE_AGENT);
                                     __hip_atomic_store(tmo, 1u, __ATOMIC_RELAXED, __HIP_MEMORY_SCOPE_AGENT); }
                    dead = true; break; }
                __builtin_amdgcn_s_sleep(2);
            }
            __builtin_amdgcn_fence(__ATOMIC_ACQUIRE, "agent");
            if (lane == 0) flag[0] = dead ? 1u : 0u;
        }
        asm volatile("s_waitcnt vmcnt(0) lgkmcnt(0)" ::: "memory"); __builtin_amdgcn_s_barrier(); asm volatile("" ::: "memory");
        const bool bad = flag[0] != 0u;
        if (lane < 32) {
            const unsigned long long* slot = (const unsigned long long*)xbuf + (size_t)(u.pm * BM + row) * 4; float mt[4], m2[4]; float ms = 0.f;
#pragma unroll
            for (int t = 0; t < 4; ++t) { if (t < ntn) { const unsigned long long w = __hip_atomic_load(slot + t, __ATOMIC_RELAXED, __HIP_MEMORY_SCOPE_AGENT); mt[t] = __uint_as_float((unsigned)w); m2[t] = __uint_as_float((unsigned)(w >> 32)); } else { mt[t] = 0.f; m2[t] = 0.f; } ms += mt[t]; }
            const float mean = ms / (float)ntn; float q = 0.f;
#pragma unroll
            for (int t = 0; t < 4; ++t) if (t < ntn) { const float dm = mt[t] - mean; q += m2[t] + 256.0f * dm * dm; }
            S[row] = (f32x2v){mean, 1.0f / sqrtf(q / (256.0f * (float)ntn) + eps)};
        }
        asm volatile("s_waitcnt lgkmcnt(0)" ::: "memory"); __builtin_amdgcn_s_barrier(); asm volatile("" ::: "memory");
        return bad;
    }
};
struct EpiLnRes {
    static constexpr bool PERM = false, AFTER_DRAIN = true;
    const float* base; float* out; int ldc; const float* bias; PanelStats st; unsigned poison;
    __device__ __forceinline__ void fused(f32x4 (&acc)[2][2][4][2], const Unit& u, int wr, int wc, int fr, int fq, PG8_LAS unsigned char* lds, int wid, int lane) const {
        typedef float f32x2v __attribute__((ext_vector_type(2)));
        const PG8_LAS f32x2v* S = (const PG8_LAS f32x2v*)(lds + 8192);
        const int col0 = u.pn * BM + wc * 32 + 4 * fq;
#pragma unroll
        for (int bj = 0; bj < 2; ++bj)
#pragma unroll
            for (int n = 0; n < 2; ++n) { const f32x4 bv = bias ? *(const f32x4*)(bias + col0 + bj * HALF + n * 16) : (f32x4){0.f, 0.f, 0.f, 0.f};
#pragma unroll
                for (int ai = 0; ai < 2; ++ai)
#pragma unroll
                    for (int m = 0; m < 4; ++m) acc[ai][bj][m][n] += bv; }
        f32x4 pre[4][2][2];
#pragma unroll
        for (int m = 0; m < 4; ++m) { const size_t off = (size_t)(u.pm * BM + wr * 64 + m * 16 + fr) * ldc + col0;
#pragma unroll
            for (int bj = 0; bj < 2; ++bj)
#pragma unroll
                for (int n = 0; n < 2; ++n) pre[m][bj][n] = *(const f32x4*)(base + off + bj * HALF + n * 16); }
        const bool bad = st.run(acc, u, wr, wc, fr, fq, lds, wid, lane) || poison != 0u;
        const float qnan = __builtin_nanf("");
#pragma unroll
        for (int ai = 0; ai < 2; ++ai)
#pragma unroll
            for (int m = 0; m < 4; ++m) { const int r = ai * HALF + wr * 64 + m * 16 + fr; const f32x2v sr = S[r]; const size_t off = (size_t)(u.pm * BM + r) * ldc + col0;
#pragma unroll
                for (int bj = 0; bj < 2; ++bj)
#pragma unroll
                    for (int n = 0; n < 2; ++n) { const f32x4 bs = ai == 0 ? pre[m][bj][n] : *(const f32x4*)(base + off + bj * HALF + n * 16); f32x4 o = bs + (acc[ai][bj][m][n] - sr.x) * sr.y;
                        if (bad) o = (f32x4){qnan, qnan, qnan, qnan}; *(f32x4*)(out + off + bj * HALF + n * 16) = o; }
                if (m & 1) asm volatile("" ::: "memory"); }
    }
};
struct EpiLnResLn {
    static constexpr bool PERM = false, AFTER_DRAIN = true;
    const float* base; float* out; bf16_t* xn; int ldc; const float* bias; PanelStats st1, st2; unsigned poison;
    __device__ __forceinline__ void fused(f32x4 (&acc)[2][2][4][2], const Unit& u, int wr, int wc, int fr, int fq, PG8_LAS unsigned char* lds, int wid, int lane) const {
        typedef float f32x2v __attribute__((ext_vector_type(2))); typedef unsigned u32x2v __attribute__((ext_vector_type(2)));
        const PG8_LAS f32x2v* S = (const PG8_LAS f32x2v*)(lds + 8192);
        const int col0 = u.pn * BM + wc * 32 + 4 * fq;
#pragma unroll
        for (int bj = 0; bj < 2; ++bj)
#pragma unroll
            for (int n = 0; n < 2; ++n) { const f32x4 bv = bias ? *(const f32x4*)(bias + col0 + bj * HALF + n * 16) : (f32x4){0.f, 0.f, 0.f, 0.f};
#pragma unroll
                for (int ai = 0; ai < 2; ++ai)
#pragma unroll
                    for (int m = 0; m < 4; ++m) acc[ai][bj][m][n] += bv; }
        bool bad = st1.run(acc, u, wr, wc, fr, fq, lds, wid, lane) || poison != 0u;
        const float qnan = __builtin_nanf("");
#pragma unroll
        for (int ai = 0; ai < 2; ++ai)
#pragma unroll
            for (int m = 0; m < 4; ++m) { const int r = ai * HALF + wr * 64 + m * 16 + fr; const f32x2v sr = S[r]; const size_t off = (size_t)(u.pm * BM + r) * ldc + col0;
#pragma unroll
                for (int bj = 0; bj < 2; ++bj)
#pragma unroll
                    for (int n = 0; n < 2; ++n) { const f32x4 bs = *(const f32x4*)(base + off + bj * HALF + n * 16); acc[ai][bj][m][n] = bs + (acc[ai][bj][m][n] - sr.x) * sr.y; }
                asm volatile("" : "+v"(acc[ai][0][m][0]), "+v"(acc[ai][0][m][1]), "+v"(acc[ai][1][m][0]), "+v"(acc[ai][1][m][1]));
                if (m & 1) asm volatile("" ::: "memory"); }
        const bool bad1 = bad;
        bad = st2.run(acc, u, wr, wc, fr, fq, lds, wid, lane) || bad;
#pragma unroll
        for (int ai = 0; ai < 2; ++ai)
#pragma unroll
            for (int m = 0; m < 4; ++m) { const int r = ai * HALF + wr * 64 + m * 16 + fr; const f32x2v sr = S[r]; const size_t off = (size_t)(u.pm * BM + r) * ldc + col0;
#pragma unroll
                for (int bj = 0; bj < 2; ++bj)
#pragma unroll
                    for (int n = 0; n < 2; ++n) { const f32x4 x1 = acc[ai][bj][m][n]; *(f32x4*)(out + off + bj * HALF + n * 16) = bad1 ? (f32x4){qnan, qnan, qnan, qnan} : x1;
                        const f32x4 o = (x1 - sr.x) * sr.y; u32x2v w; w.x = cvt_pk_bf16(o[0], o[1]); w.y = cvt_pk_bf16(o[2], o[3]);
                        if (bad) { w.x = 0x7fc07fc0u; w.y = 0x7fc07fc0u; } *(u32x2v*)(xn + off + bj * HALF + n * 16) = w; }
                asm volatile("" ::: "memory"); }
    }
};

template <class Epi, class Sched, bool ALIGN_EPI = false, bool SP2 = false>
__device__ __forceinline__ void gemm_phase(PG8_LAS unsigned char* lds, const Gemm g, const Sched& S, const Epi& E) {
    int tid_ = threadIdx.x; asm volatile("" : "+v"(tid_)); const int tid = tid_, wid = __builtin_amdgcn_readfirstlane(tid >> 6), lane = tid & 63, wr = wid >> 2, wc = wid & 3, fr = lane & 15, fq = lane >> 4;
    const int K = g.K, nt = K / BK;
    unsigned voffA[2], voffB[2];
#pragma unroll
    for (int i = 0; i < 2; ++i) { int R, C; stage_rc(tid * 16 + i * 8192, R, C); const int Rb = Epi::PERM ? ((R & ~31) + perm32(R & 31)) : R;
        voffA[i] = (unsigned)(R * K + C) * 2u; voffB[i] = (unsigned)(Rb * K + C) * 2u; }
    const size_t kstep = (size_t)(BK * 2);
    const size_t hstep = (size_t)HALF * K * 2;
    const size_t tstep = 2 * hstep;
    const unsigned ldsw = (unsigned)wid * 1024u;
    const int aoff = lds_byte(wr * 64 + fr, fq * 8), boff = lds_byte(wc * 32 + fr, fq * 8);
#define PG8_SA(b, h) (((b) * 2 + (h)) * HTB)
#define PG8_SB(b, h) ((4 + (b) * 2 + (h)) * HTB)
#define PG8_STAGE(bufoff, gbase, voff) do { _Pragma("unroll") for (int _i = 0; _i < 2; ++_i) \
        __builtin_amdgcn_global_load_lds((const unsigned*)((const char*)(gbase) + (voff)[_i]), (PG8_LAS unsigned*)(lds + (bufoff) + ldsw + _i * 8192), 16, 0, 0); } while (0)
#define PG8_LDA(dst, b, h) do { _Pragma("unroll") for (int m = 0; m < 4; ++m) _Pragma("unroll") for (int k = 0; k < 2; ++k) dst[m][k] = *(const PG8_LAS bf16x8*)(lds + PG8_SA(b, h) + aoff + m * 2048 + k * 1024); } while (0)
#define PG8_LDB(dst, b, h) do { _Pragma("unroll") for (int n = 0; n < 2; ++n) _Pragma("unroll") for (int k = 0; k < 2; ++k) dst[n][k] = *(const PG8_LAS bf16x8*)(lds + PG8_SB(b, h) + boff + n * 2048 + k * 1024); } while (0)
#define PG8_MMA(ai, bj, At, Bt) do { __builtin_amdgcn_s_setprio(1); _Pragma("unroll") for (int m = 0; m < 4; ++m) _Pragma("unroll") for (int n = 0; n < 2; ++n) _Pragma("unroll") for (int k = 0; k < 2; ++k) \
        acc[ai][bj][m][n] = __builtin_amdgcn_mfma_f32_16x16x32_bf16(Bt[n][k], At[m][k], acc[ai][bj][m][n], 0, 0, 0); __builtin_amdgcn_s_setprio(0); } while (0)
#define PG8_WAIT_V(n) asm volatile("s_waitcnt vmcnt(" #n ")" ::: "memory")
#define PG8_WAIT_L(n) asm volatile("s_waitcnt lgkmcnt(" #n ")" ::: "memory")
#define PG8_BAR __builtin_amdgcn_s_barrier()
#define PG8_SCHED __builtin_amdgcn_sched_barrier(0)
    Unit cur, nxt; int ui = 0;
    if (!S.next(0, cur)) return;
    f32x4 acc[2][2][4][2];
#pragma unroll
    for (int a = 0; a < 2; ++a)
#pragma unroll
        for (int b = 0; b < 2; ++b)
#pragma unroll
            for (int m = 0; m < 4; ++m)
#pragma unroll
                for (int n = 0; n < 2; ++n) acc[a][b][m][n] = (f32x4){0.f, 0.f, 0.f, 0.f};
    bf16x8 At[4][2], B0[2][2], B1[2][2];
    const char* cA = (const char*)g.A + (size_t)cur.pm * tstep; const char* cB = (const char*)g.Bt + (size_t)cur.pn * tstep;
    S.a_ready(cur);
    if constexpr (SP2) {
        PG8_STAGE(PG8_SB(0, 0), cB, voffB); PG8_STAGE(PG8_SB(0, 1), cB + hstep, voffB); PG8_STAGE(PG8_SA(0, 0), cA, voffA); PG8_STAGE(PG8_SA(0, 1), cA + hstep, voffA);
        if (wr == 1) PG8_BAR;
        PG8_WAIT_V(2); PG8_BAR;
        PG8_STAGE(PG8_SB(1, 0), cB + kstep, voffB); PG8_STAGE(PG8_SA(1, 0), cA + kstep, voffA); PG8_STAGE(PG8_SB(1, 1), cB + hstep + kstep, voffB);
        PG8_WAIT_V(6); PG8_BAR;
    } else {
        PG8_STAGE(PG8_SB(0, 0), cB, voffB); PG8_STAGE(PG8_SA(0, 0), cA, voffA); PG8_STAGE(PG8_SB(0, 1), cB + hstep, voffB); PG8_STAGE(PG8_SA(0, 1), cA + hstep, voffA);
        if (wr == 1) PG8_BAR;
        PG8_WAIT_V(4); PG8_BAR;
        PG8_STAGE(PG8_SB(1, 0), cB + kstep, voffB); PG8_STAGE(PG8_SA(1, 0), cA + kstep, voffA); PG8_STAGE(PG8_SB(1, 1), cB + hstep + kstep, voffB);
        PG8_WAIT_V(6); PG8_BAR;
    }
    for (;;) {
        const bool has_next = S.next(ui + 1, nxt);
        const char* nA = has_next ? (const char*)g.A + (size_t)nxt.pm * tstep : cA; const char* nB = has_next ? (const char*)g.Bt + (size_t)nxt.pn * tstep : cB;
        for (int t = 0; t < nt; t += 2) {
            const bool last = (t == nt - 2);
            const char* a1 = cA + (size_t)(t + 1) * kstep;
            const char* a2 = last ? nA : cA + (size_t)(t + 2) * kstep; const char* b2 = last ? nB : cB + (size_t)(t + 2) * kstep;
            const char* a3 = a2 + kstep; const char* b3 = b2 + kstep;
            if (last && has_next) S.a_ready(nxt);
            if constexpr (SP2) {
            PG8_LDB(B0, 0, 0); PG8_LDB(B1, 0, 1); PG8_SCHED; PG8_LDA(At, 0, 0); PG8_STAGE(PG8_SA(1, 1), a1 + hstep, voffA);
            PG8_WAIT_V(8); PG8_WAIT_L(0); PG8_BAR; PG8_MMA(0, 0, At, B0); PG8_MMA(0, 1, At, B1); PG8_BAR; PG8_SCHED;
            PG8_LDA(At, 0, 1); PG8_STAGE(PG8_SB(0, 0), b2, voffB); PG8_STAGE(PG8_SB(0, 1), b2 + hstep, voffB); PG8_STAGE(PG8_SA(0, 0), a2, voffA);
            PG8_WAIT_V(8); PG8_WAIT_L(0); PG8_BAR; PG8_MMA(1, 0, At, B0); PG8_MMA(1, 1, At, B1); PG8_BAR; PG8_SCHED;
            PG8_LDB(B0, 1, 0); PG8_LDB(B1, 1, 1); PG8_SCHED; PG8_LDA(At, 1, 0); PG8_STAGE(PG8_SA(0, 1), a2 + hstep, voffA);
            PG8_WAIT_V(8); PG8_WAIT_L(0); PG8_BAR; PG8_MMA(0, 0, At, B0); PG8_MMA(0, 1, At, B1); PG8_BAR; PG8_SCHED;
            PG8_LDA(At, 1, 1); PG8_STAGE(PG8_SB(1, 0), b3, voffB); PG8_STAGE(PG8_SB(1, 1), b3 + hstep, voffB); PG8_STAGE(PG8_SA(1, 0), a3, voffA);
            PG8_WAIT_V(8); PG8_WAIT_L(0); PG8_BAR; PG8_MMA(1, 0, At, B0); PG8_MMA(1, 1, At, B1); PG8_BAR; PG8_SCHED;
            } else {
            PG8_LDB(B0, 0, 0); PG8_SCHED; PG8_LDA(At, 0, 0); PG8_STAGE(PG8_SA(1, 1), a1 + hstep, voffA);
            PG8_WAIT_L(8); PG8_BAR; PG8_WAIT_L(0); PG8_MMA(0, 0, At, B0); PG8_BAR; PG8_SCHED;
            PG8_LDB(B1, 0, 1); PG8_STAGE(PG8_SB(0, 0), b2, voffB);
            PG8_BAR; PG8_WAIT_L(0); PG8_MMA(0, 1, At, B1); PG8_BAR;
            PG8_LDA(At, 0, 1); PG8_STAGE(PG8_SA(0, 0), a2, voffA);
            PG8_BAR; PG8_WAIT_L(0); PG8_MMA(1, 0, At, B0); PG8_BAR; PG8_SCHED;
            PG8_STAGE(PG8_SB(0, 1), b2 + hstep, voffB);
            PG8_WAIT_V(6); PG8_BAR; PG8_MMA(1, 1, At, B1); PG8_BAR;
            PG8_LDB(B0, 1, 0); PG8_SCHED; PG8_LDA(At, 1, 0); PG8_STAGE(PG8_SA(0, 1), a2 + hstep, voffA);
            PG8_WAIT_L(8); PG8_BAR; PG8_WAIT_L(0); PG8_MMA(0, 0, At, B0); PG8_BAR; PG8_SCHED;
            PG8_LDB(B1, 1, 1); PG8_STAGE(PG8_SB(1, 0), b3, voffB);
            PG8_BAR; PG8_WAIT_L(0); PG8_MMA(0, 1, At, B1); PG8_BAR;
            PG8_LDA(At, 1, 1); PG8_STAGE(PG8_SA(1, 0), a3, voffA);
            PG8_BAR; PG8_WAIT_L(0); PG8_MMA(1, 0, At, B0); PG8_BAR; PG8_SCHED;
            PG8_STAGE(PG8_SB(1, 1), b3 + hstep, voffB);
            PG8_WAIT_V(6); PG8_BAR; PG8_MMA(1, 1, At, B1); PG8_BAR;
            }
        }
        if constexpr (ALIGN_EPI) { if (wr == 0) PG8_BAR; }
        if constexpr (!Epi::AFTER_DRAIN) { E(acc, cur, wr, wc, fr, fq); S.done(cur); }
        if (!has_next) break;
#pragma unroll
        for (int a = 0; a < 2; ++a)
#pragma unroll
            for (int b = 0; b < 2; ++b)
#pragma unroll
                for (int m = 0; m < 4; ++m)
#pragma unroll
                    for (int n = 0; n < 2; ++n) acc[a][b][m][n] = (f32x4){0.f, 0.f, 0.f, 0.f};
        cur = nxt; cA = nA; cB = nB; ++ui;
        if constexpr (ALIGN_EPI) { if (wr == 1) PG8_BAR; }
    }
    PG8_WAIT_V(0);
    if constexpr (!ALIGN_EPI) { if (wr == 0) PG8_BAR; }
    PG8_BAR;
    if constexpr (Epi::AFTER_DRAIN) { E.fused(acc, cur, wr, wc, fr, fq, lds, wid, lane); S.done(cur); }
#undef PG8_SA
#undef PG8_SB
#undef PG8_STAGE
#undef PG8_LDA
#undef PG8_LDB
#undef PG8_MMA
#undef PG8_WAIT_V
#undef PG8_WAIT_L
#undef PG8_BAR
#undef PG8_SCHED
}
}

#define LAS __attribute__((address_space(3)))
typedef unsigned short bf16;
typedef float f32x4 __attribute__((ext_vector_type(4)));
typedef float f32x16 __attribute__((ext_vector_type(16)));
typedef short bf16x8 __attribute__((ext_vector_type(8)));
typedef short s16x4 __attribute__((ext_vector_type(4)));
typedef unsigned u32x4 __attribute__((ext_vector_type(4)));
typedef unsigned u32x2 __attribute__((ext_vector_type(2)));

constexpr int S = 16384, D = 1024, F = 2816, F2 = 5632, DEPTH = 4;
constexpr float LN_EPS = 1e-5f;
constexpr float ALPHA = 1.6817928305074290f;
constexpr float L2E = 1.4426950408889634f, LN2 = 0.6931471805599453f;
constexpr size_t MiB = 1u << 20;
constexpr size_t WS_KMS = 0;
constexpr size_t WS_COS = 1 * MiB, WS_SIN = 3 * MiB;
constexpr size_t WS_W0 = 5 * MiB, WS_W1 = 30 * MiB;
constexpr size_t WO_QKV = 0, WO_O = 6 * MiB, WO_UP = 8 * MiB, WO_DN = 19 * MiB;
constexpr size_t WS_H = 55 * MiB;
constexpr size_t WS_Q = 87 * MiB, WS_K = 119 * MiB, WS_V = 151 * MiB, WS_O = 183 * MiB;
constexpr size_t WS_U = 87 * MiB;
constexpr size_t WS_A = 263 * MiB;
constexpr size_t WS_END = 351 * MiB;
static_assert(WS_K - WS_Q == 32 * MiB && WS_V - WS_K == 32 * MiB, "EpiQKV strides");
constexpr int LDS_BYTES = 147456;
constexpr int ATT_SCR_OFF = 136 * 1024;

__device__ __forceinline__ unsigned cvtpk(float lo, float hi) {
    typedef float f2 __attribute__((ext_vector_type(2))); typedef __bf16 b2 __attribute__((ext_vector_type(2)));
    f2 v = {lo, hi}; b2 b = __builtin_convertvector(v, b2); return __builtin_bit_cast(unsigned, b);
}
__device__ __forceinline__ float bf2f(unsigned short h) { return __uint_as_float(((unsigned)h) << 16); }
__device__ __forceinline__ int crow(int r, int hi) { return (r & 3) + 8 * (r >> 2) + 4 * hi; }
template <int s> __device__ __forceinline__ bf16x8 pack8(const f32x16& p) {
    u32x4 w; w.x = cvtpk(p[8 * s + 0], p[8 * s + 1]); w.y = cvtpk(p[8 * s + 2], p[8 * s + 3]); w.z = cvtpk(p[8 * s + 4], p[8 * s + 5]); w.w = cvtpk(p[8 * s + 6], p[8 * s + 7]);
    return __builtin_bit_cast(bf16x8, w);
}
__device__ __forceinline__ s16x4 vtr(LAS const unsigned char* p) {
    typedef short v4i16_t __attribute__((ext_vector_type(4)));
    return __builtin_bit_cast(s16x4, __builtin_amdgcn_ds_read_tr16_b64_v4i16((LAS v4i16_t*)p));
}
__device__ __forceinline__ bf16x8 vfrag(LAS const unsigned char* p, int pitch8) {
    const s16x4 lo = vtr(p), hi = vtr(p + pitch8);
    return (bf16x8){lo[0], lo[1], lo[2], lo[3], hi[0], hi[1], hi[2], hi[3]};
}
__device__ __forceinline__ int otid() { int t = threadIdx.x; asm volatile("" : "+v"(t)); return t; }
#define MFMA32(a, b, c) __builtin_amdgcn_mfma_f32_32x32x16_bf16((a), (b), (c), 0, 0, 0)

struct EpiQKV {
    static constexpr bool PERM = true, AFTER_DRAIN = false;
    bf16 *Q; const float* cosT; const float* sinT; float* kms; int even;
    __device__ __forceinline__ void operator()(const pg8::f32x4 (&acc)[2][2][4][2], const pg8::Unit& u, int wr, int wc, int fr, int fq) const {
        const int sec = u.pn >> 2, colt = (u.pn & 3) * 256;
        bf16* base = Q + (size_t)sec * (size_t)(16u << 20);
        if (even) {
            const int g4 = ((wc & 1) * 4 + fq) * 4;
            const float qs = sec == 0 ? 0.125f : 1.0f;
#pragma unroll
            for (int ai = 0; ai < 2; ++ai)
#pragma unroll
                for (int m = 0; m < 4; ++m) {
                    const int row = u.pm * 256 + ai * 128 + wr * 64 + m * 16 + fr;
                    f32x4 c = (f32x4){1.f, 1.f, 1.f, 1.f}, s = (f32x4){0.f, 0.f, 0.f, 0.f};
                    if (sec < 2) { c = *(const f32x4*)(cosT + (size_t)row * 32 + g4); s = *(const f32x4*)(sinT + (size_t)row * 32 + g4); }
#pragma unroll
                    for (int bj = 0; bj < 2; ++bj) {
                        const f32x4 v0 = acc[ai][bj][m][0], v1 = acc[ai][bj][m][1];
                        const f32x4 o1 = (v0 * c - v1 * s) * qs, o2 = (v1 * c + v0 * s) * qs;
                        bf16* p = base + (size_t)row * 1024 + colt + 128 * bj + (wc >> 1) * 64 + g4;
                        u32x2 w1, w2; w1.x = cvtpk(o1[0], o1[1]); w1.y = cvtpk(o1[2], o1[3]); w2.x = cvtpk(o2[0], o2[1]); w2.y = cvtpk(o2[2], o2[3]);
                        *(u32x2*)p = w1; *(u32x2*)(p + 32) = w2;
                    }
                }
            if (u.pn == 4) {
#pragma unroll
                for (int bj = 0; bj < 2; ++bj) {
                    f32x4 c1 = (f32x4){0.f, 0.f, 0.f, 0.f}, c2 = c1;
#pragma unroll
                    for (int ai = 0; ai < 2; ++ai)
#pragma unroll
                        for (int m = 0; m < 4; ++m) {
                            const int row = u.pm * 256 + ai * 128 + wr * 64 + m * 16 + fr;
                            const f32x4 c = *(const f32x4*)(cosT + (size_t)row * 32 + g4), s = *(const f32x4*)(sinT + (size_t)row * 32 + g4);
                            const f32x4 v0 = acc[ai][bj][m][0], v1 = acc[ai][bj][m][1];
                            c1 += v0 * c - v1 * s; c2 += v1 * c + v0 * s;
                        }
#pragma unroll
                    for (int j = 0; j < 4; ++j) {
                        float a = c1[j], b = c2[j];
                        a += __shfl_xor(a, 1); a += __shfl_xor(a, 2); a += __shfl_xor(a, 4); a += __shfl_xor(a, 8);
                        b += __shfl_xor(b, 1); b += __shfl_xor(b, 2); b += __shfl_xor(b, 4); b += __shfl_xor(b, 8);
                        if (fr == 0) { float* kp = kms + (size_t)u.pm * 256 + (2 * bj + (wc >> 1)) * 64 + g4 + j; atomicAdd(kp, a); atomicAdd(kp + 32, b); }
                    }
                }
            }
        } else {
            const float qs = sec == 0 ? 0.08838834764831845f : 1.0f;
#pragma unroll
            for (int ai = 0; ai < 2; ++ai)
#pragma unroll
                for (int m = 0; m < 4; ++m) {
                    const int row = u.pm * 256 + ai * 128 + wr * 64 + m * 16 + fr;
#pragma unroll
                    for (int bj = 0; bj < 2; ++bj) {
                        const f32x4 v0 = acc[ai][bj][m][0] * qs, v1 = acc[ai][bj][m][1] * qs;
                        u32x4 w; w.x = cvtpk(v0[0], v0[1]); w.y = cvtpk(v0[2], v0[3]); w.z = cvtpk(v1[0], v1[1]); w.w = cvtpk(v1[2], v1[3]);
                        *(u32x4*)(base + (size_t)row * 1024 + colt + 128 * bj + 32 * wc + 8 * fq) = w;
                    }
                }
        }
    }
};
struct EpiResid {
    static constexpr bool PERM = false, AFTER_DRAIN = false;
    const float* base; float* out;
    __device__ __forceinline__ void operator()(const pg8::f32x4 (&acc)[2][2][4][2], const pg8::Unit& u, int wr, int wc, int fr, int fq) const {
        const int col0 = u.pn * 256 + wc * 32 + 4 * fq;
#pragma unroll
        for (int ai = 0; ai < 2; ++ai)
#pragma unroll
            for (int m = 0; m < 4; ++m) {
                const size_t off = (size_t)(u.pm * 256 + ai * 128 + wr * 64 + m * 16 + fr) * 1024 + col0;
#pragma unroll
                for (int bj = 0; bj < 2; ++bj)
#pragma unroll
                    for (int n = 0; n < 2; ++n) {
                        const f32x4 bs = *(const f32x4*)(base + off + bj * 128 + n * 16);
                        *(f32x4*)(out + off + bj * 128 + n * 16) = bs * ALPHA + acc[ai][bj][m][n];
                    }
            }
    }
};

__device__ __forceinline__ int vmap(int mode, int n) {
    if (mode == 1) { const int d = n & 63, dd = d & 31; return (n & ~63) + ((dd >> 2) << 3) + ((d >> 5) << 2) + (dd & 3); }
    if (mode == 2) { const int isv = n >= F ? 1 : 0, ch = n - isv * F; return ((ch >> 2) << 3) + (isv << 2) + (ch & 3); }
    return n;
}
__device__ __forceinline__ void wconv_item(const float* W, int K, int N, bf16* WT, int mode, LAS float* scr, int item, int lane) {
    const int nblk = N / 32, kb = item / nblk, nb = item % nblk, k0 = 64 * kb, n0 = 32 * nb;
#pragma unroll 8
    for (int i = 0; i < 32; ++i) { const int kk = 2 * i + (lane >> 5); scr[kk * 33 + (lane & 31)] = W[(size_t)(k0 + kk) * N + n0 + (lane & 31)]; }
    asm volatile("s_waitcnt lgkmcnt(0)" ::: "memory");
    const int c = lane & 7;
#pragma unroll
    for (int j = 0; j < 4; ++j) { const int n = (lane >> 3) + 8 * j; const LAS float* s = scr + (8 * c) * 33 + n;
        u32x4 o; o.x = cvtpk(s[0 * 33], s[1 * 33]); o.y = cvtpk(s[2 * 33], s[3 * 33]); o.z = cvtpk(s[4 * 33], s[5 * 33]); o.w = cvtpk(s[6 * 33], s[7 * 33]);
        *(u32x4*)(WT + (size_t)vmap(mode, n0 + n) * K + k0 + 8 * c) = o; }
    asm volatile("s_waitcnt lgkmcnt(0)" ::: "memory");
}
constexpr int WI_QKV = 16 * 96, WI_O = 16 * 32, WI_UP = 16 * 176, WI_DN = 44 * 32, WI_ALL = WI_QKV + WI_O + WI_UP + WI_DN;
struct Params { const float* in[13]; float* out; unsigned char* ws; };
__device__ __forceinline__ void wconv_layer_item(const Params& P, int L, int it, LAS float* scr, int lane) {
    unsigned char* wb = P.ws + ((L & 1) ? WS_W1 : WS_W0);
    const int h = L >> 1, ev = !(L & 1);
    if (it < WI_QKV) { wconv_item((ev ? P.in[1] : P.in[3]) + (size_t)h * D * 3072, D, 3072, (bf16*)(wb + WO_QKV), ev ? 1 : 0, scr, it, lane); return; } it -= WI_QKV;
    if (it < WI_O) { wconv_item((ev ? P.in[2] : P.in[4]) + (size_t)h * D * D, D, D, (bf16*)(wb + WO_O), 0, scr, it, lane); return; } it -= WI_O;
    if (it < WI_UP) { wconv_item(P.in[7] + (size_t)L * D * F2, D, F2, (bf16*)(wb + WO_UP), 2, scr, it, lane); return; } it -= WI_UP;
    wconv_item(P.in[10] + (size_t)L * F * D, F, D, (bf16*)(wb + WO_DN), 0, scr, it, lane);
}

__device__ __forceinline__ float wave_sum(float v) {
#pragma unroll
    for (int o = 1; o < 64; o <<= 1) v += __shfl_xor(v, o);
    return v;
}
__device__ __forceinline__ void ln_row(float* yrow, bf16* hrow, const float* g, const float* b, int lane) {
    f32x4* yr = (f32x4*)yrow + lane;
    f32x4 v[4]; float s = 0.f;
#pragma unroll
    for (int j = 0; j < 4; ++j) { v[j] = yr[64 * j]; s += (v[j].x + v[j].y) + (v[j].z + v[j].w); }
    const float mean = wave_sum(s) * (1.f / D); float s2 = 0.f;
#pragma unroll
    for (int j = 0; j < 4; ++j) { v[j] = v[j] - mean; s2 += (v[j].x * v[j].x + v[j].y * v[j].y) + (v[j].z * v[j].z + v[j].w * v[j].w); }
    const float rstd = 1.f / sqrtf(wave_sum(s2) * (1.f / D) + LN_EPS);
    u32x2* o8 = (u32x2*)hrow + lane;
#pragma unroll
    for (int j = 0; j < 4; ++j) {
        const f32x4 gg = *((const f32x4*)g + lane + 64 * j), bb = *((const f32x4*)b + lane + 64 * j);
        const f32x4 o = v[j] * rstd * gg + bb;
        yr[64 * j] = o;
        u32x2 w; w.x = cvtpk(o.x, o.y); w.y = cvtpk(o.z, o.w); o8[64 * j] = w;
    }
}

__device__ __forceinline__ void unpack8(const u32x4 w, f32x4& g, f32x4& v) {
    g = (f32x4){__uint_as_float(w.x << 16), __uint_as_float(w.x & 0xffff0000u), __uint_as_float(w.y << 16), __uint_as_float(w.y & 0xffff0000u)};
    v = (f32x4){__uint_as_float(w.z << 16), __uint_as_float(w.z & 0xffff0000u), __uint_as_float(w.w << 16), __uint_as_float(w.w & 0xffff0000u)};
}
__device__ __forceinline__ void conv_item(const bf16* U, bf16* A, const float* cw, const float* cb, int item, int lane) {
    const int chunk = item / 11, cbk = item % 11, cg_ = cbk * 64 + lane, v0 = cg_ * 8, ch0 = cg_ * 4, t0 = chunk * 32;
    f32x4 wg[3], wv[3];
#pragma unroll
    for (int j = 0; j < 3; ++j) { wg[j] = *(const f32x4*)(cw + (size_t)j * F2 + ch0); wv[j] = *(const f32x4*)(cw + (size_t)j * F2 + F + ch0); }
    const f32x4 bg = *(const f32x4*)(cb + ch0), bv = *(const f32x4*)(cb + F + ch0);
    f32x4 g2 = (f32x4){0.f, 0.f, 0.f, 0.f}, v2 = g2, g1 = g2, v1 = g2;
    if (t0 >= 2) { unpack8(*(const u32x4*)(U + (size_t)(t0 - 2) * F2 + v0), g2, v2); unpack8(*(const u32x4*)(U + (size_t)(t0 - 1) * F2 + v0), g1, v1); }
#pragma unroll 4
    for (int t = t0; t < t0 + 32; ++t) {
        f32x4 g0, vv0; unpack8(*(const u32x4*)(U + (size_t)t * F2 + v0), g0, vv0);
        const f32x4 cgv = bg + wg[0] * g2 + wg[1] * g1 + wg[2] * g0;
        const f32x4 cvv = bv + wv[0] * v2 + wv[1] * v1 + wv[2] * vv0;
        f32x4 o;
#pragma unroll
        for (int j = 0; j < 4; ++j) { const float x = cgv[j]; o[j] = x / (1.0f + __builtin_amdgcn_exp2f(-x * L2E)) * cvv[j]; }
        u32x2 w; w.x = cvtpk(o[0], o[1]); w.y = cvtpk(o[2], o[3]);
        *(u32x2*)(A + (size_t)t * F + ch0) = w;
        g2 = g1; v2 = v1; g1 = g0; v1 = vv0;
    }
}

__device__ __forceinline__ void softmax_block(const f32x16& z, unsigned vmask, float& m, float& l, f32x16 (&o)[2], LAS float* wsf, LAS const unsigned char* vp, int VP, int r, int hh) {
    float zm = -1e30f;
#pragma unroll
    for (int i = 0; i < 16; ++i) zm = fmaxf(zm, ((vmask >> i) & 1u) ? z[i] : -1e30f);
    zm = fmaxf(zm, __shfl_xor(zm, 32));
    const float mn = fmaxf(m, zm);
    if (__any(mn > m)) {
        const float al = __builtin_amdgcn_exp2f((m - mn) * L2E);
        l *= al;
        if (hh == 0) wsf[r] = al;
        asm volatile("s_waitcnt lgkmcnt(0)" ::: "memory");
#pragma unroll
        for (int i = 0; i < 16; ++i) { const float f = wsf[crow(i, hh)]; o[0][i] *= f; o[1][i] *= f; }
        asm volatile("s_waitcnt lgkmcnt(0)" ::: "memory");
        m = mn;
    }
    f32x16 p; float ls = 0.f;
#pragma unroll
    for (int i = 0; i < 16; ++i) { const float pi = ((vmask >> i) & 1u) ? __builtin_amdgcn_exp2f((z[i] - m) * L2E) : 0.f; p[i] = pi; ls += pi; }
    l += ls;
    const bf16x8 a0 = pack8<0>(p), a1 = pack8<1>(p);
#pragma unroll
    for (int db = 0; db < 2; ++db) {
        o[db] = MFMA32(a0, vfrag(vp + db * 64, 8 * VP), o[db]);
        o[db] = MFMA32(a1, vfrag(vp + 16 * VP + db * 64, 8 * VP), o[db]);
    }
}
#define FINISH_STORE(ROWEXPR) do { \
    const float lt = l + __shfl_xor(l, 32); \
    if (hh == 0) wsf[r] = 1.0f / lt; \
    asm volatile("s_waitcnt lgkmcnt(0)" ::: "memory"); \
    _Pragma("unroll") for (int i = 0; i < 16; ++i) { const float f = wsf[crow(i, hh)]; const int qi = crow(i, hh); const size_t t_ = (size_t)(ROWEXPR); \
        _Pragma("unroll") for (int db = 0; db < 2; ++db) Ob[t_ * 1024 + hcol + db * 32 + r] = (bf16)(cvtpk(o[db][i] * f, 0.f) & 0xffffu); } \
    asm volatile("s_waitcnt lgkmcnt(0)" ::: "memory"); } while (0)

__device__ __forceinline__ void moba_unit(LAS unsigned char* lds, const bf16* Qb, const bf16* Kb, const bf16* Vb, bf16* Ob, const float* kms, int head, int qb) {
    const int tid = otid(), lane = tid & 63, wid = __builtin_amdgcn_readfirstlane(tid >> 6), r = lane & 31, hh = lane >> 5;
    constexpr int KP = 144, VP = 192, KBY = 64 * KP, VBY = 64 * VP, BUF = KBY + VBY;
    const int qw0 = qb * 256 + wid * 32, hcol = head * 64;
    LAS float* wsf = (LAS float*)(lds + ATT_SCR_OFF + wid * 128);
    bf16x8 qf[4];
#pragma unroll
    for (int ks = 0; ks < 4; ++ks) qf[ks] = *(const bf16x8*)(Qb + (size_t)(qw0 + r) * 1024 + hcol + ks * 16 + hh * 8);
    unsigned mlo = 0u, mhi = 0u;
    if (qb > 0) {
        f32x16 gt[2];
#pragma unroll
        for (int nb = 0; nb < 2; ++nb) {
            gt[nb] = (f32x16){0.f, 0.f, 0.f, 0.f, 0.f, 0.f, 0.f, 0.f, 0.f, 0.f, 0.f, 0.f, 0.f, 0.f, 0.f, 0.f};
#pragma unroll
            for (int ks = 0; ks < 4; ++ks) {
                const float* kp = kms + (size_t)(nb * 32 + r) * 256 + hcol + ks * 16 + hh * 8;
                const f32x4 a = *(const f32x4*)kp * (1.0f / 256.0f), b = *(const f32x4*)(kp + 4) * (1.0f / 256.0f);
                u32x4 w; w.x = cvtpk(a[0], a[1]); w.y = cvtpk(a[2], a[3]); w.z = cvtpk(b[0], b[1]); w.w = cvtpk(b[2], b[3]);
                gt[nb] = MFMA32(__builtin_bit_cast(bf16x8, w), qf[ks], gt[nb]);
            }
        }
        float ta = -INFINITY, tb = -INFINITY, tc = -INFINITY;
#pragma unroll
        for (int nb = 0; nb < 2; ++nb)
#pragma unroll
            for (int i = 0; i < 16; ++i) {
                const int n = nb * 32 + crow(i, hh);
                const float v = n < qb ? gt[nb][i] : -INFINITY; gt[nb][i] = v;
                tc = fmaxf(tc, fminf(tb, v)); tb = fmaxf(tb, fminf(ta, v)); ta = fmaxf(ta, v);
            }
        const float oa = __shfl_xor(ta, 32), ob = __shfl_xor(tb, 32), oc = __shfl_xor(tc, 32);
        { float v = oa; tc = fmaxf(tc, fminf(tb, v)); tb = fmaxf(tb, fminf(ta, v)); ta = fmaxf(ta, v);
          v = ob; tc = fmaxf(tc, fminf(tb, v)); tb = fmaxf(tb, fminf(ta, v)); ta = fmaxf(ta, v);
          v = oc; tc = fmaxf(tc, fminf(tb, v)); tb = fmaxf(tb, fminf(ta, v)); ta = fmaxf(ta, v); }
#pragma unroll
        for (int i = 0; i < 16; ++i) {
            const int n0 = crow(i, hh);
            if (n0 < qb && gt[0][i] >= tc) mlo |= 1u << n0;
            if (n0 + 32 < qb && gt[1][i] >= tc) mhi |= 1u << n0;
        }
        mlo |= __shfl_xor(mlo, 32); mhi |= __shfl_xor(mhi, 32);
    }
    float m = -1e30f, l = 0.f; f32x16 o[2];
    o[0] = (f32x16){0.f, 0.f, 0.f, 0.f, 0.f, 0.f, 0.f, 0.f, 0.f, 0.f, 0.f, 0.f, 0.f, 0.f, 0.f, 0.f}; o[1] = o[0];
    const int NT = 4 * (qb + 1);
    const int srow = tid >> 3, sc8 = tid & 7;
    u32x4 kreg, vreg;
    { const int k0 = qb * 256; kreg = *(const u32x4*)(Kb + (size_t)(k0 + srow) * 1024 + hcol + sc8 * 8); vreg = *(const u32x4*)(Vb + (size_t)(k0 + srow) * 1024 + hcol + sc8 * 8); }
    *(LAS u32x4*)(lds + srow * KP + sc8 * 16) = kreg; *(LAS u32x4*)(lds + KBY + srow * VP + sc8 * 16) = vreg;
    __syncthreads();
    int buf = 0;
    for (int T = 0; T < NT; ++T) {
        const int nn = qb - (T >> 2), k0 = nn * 256 + (T & 3) * 64;
        if (T + 1 < NT) { const int k1 = (qb - ((T + 1) >> 2)) * 256 + ((T + 1) & 3) * 64;
            kreg = *(const u32x4*)(Kb + (size_t)(k1 + srow) * 1024 + hcol + sc8 * 8); vreg = *(const u32x4*)(Vb + (size_t)(k1 + srow) * 1024 + hcol + sc8 * 8); }
        const bool own = (nn == qb);
        const bool sel = own ? true : (((nn < 32 ? (mlo >> nn) : (mhi >> (nn - 32))) & 1u) != 0u);
        if (__any(sel)) {
            LAS const unsigned char* kb_ = lds + buf * BUF; LAS const unsigned char* vb_ = kb_ + KBY;
#pragma unroll
            for (int kb = 0; kb < 2; ++kb) {
                const int kb0 = k0 + kb * 32;
                if (own && kb0 > qw0 + 31) continue;
                f32x16 z = (f32x16){0.f, 0.f, 0.f, 0.f, 0.f, 0.f, 0.f, 0.f, 0.f, 0.f, 0.f, 0.f, 0.f, 0.f, 0.f, 0.f};
                LAS const unsigned char* kp = kb_ + (kb * 32 + r) * KP + hh * 16;
#pragma unroll
                for (int ks = 0; ks < 4; ++ks) z = MFMA32(*(LAS const bf16x8*)(kp + ks * 32), qf[ks], z);
                unsigned vm = 0u;
                if (own) {
#pragma unroll
                    for (int i = 0; i < 16; ++i) vm |= ((kb0 + crow(i, hh)) <= (qw0 + r)) ? (1u << i) : 0u;
                } else vm = sel ? 0xffffu : 0u;
                LAS const unsigned char* vp = vb_ + (kb * 32 + 4 * hh + ((lane & 15) >> 2)) * VP + (((lane >> 4) & 1) * 16 + (lane & 3) * 4) * 2;
                softmax_block(z, vm, m, l, o, wsf, vp, VP, r, hh);
            }
        }
        if (T + 1 < NT) { LAS unsigned char* d = lds + (buf ^ 1) * BUF; *(LAS u32x4*)(d + srow * KP + sc8 * 16) = kreg; *(LAS u32x4*)(d + KBY + srow * VP + sc8 * 16) = vreg; }
        __syncthreads();
        buf ^= 1;
    }
    FINISH_STORE(qw0 + qi);
    __syncthreads();
}

__device__ __forceinline__ void dilated_unit(LAS unsigned char* lds, const bf16* Qb, const bf16* Kb, const bf16* Vb, bf16* Ob, int head, int tb) {
    const int tid = otid(), lane = tid & 63, wid = __builtin_amdgcn_readfirstlane(tid >> 6), r = lane & 31, hh = lane >> 5;
    constexpr int VP = 192;
    const int hcol = head * 64, T0 = tb * 512;
    LAS float* wsf = (LAS float*)(lds + ATT_SCR_OFF + wid * 128);
    LAS unsigned char* vst = lds + wid * (32 * VP);
    for (int e = 0; e < 2; ++e) {
        const int c = 2 * wid + e;
        bf16x8 qf[4];
#pragma unroll
        for (int ks = 0; ks < 4; ++ks) qf[ks] = *(const bf16x8*)(Qb + (size_t)(T0 + c + 16 * r) * 1024 + hcol + ks * 16 + hh * 8);
        float m = -1e30f, l = 0.f; f32x16 o[2];
        o[0] = (f32x16){0.f, 0.f, 0.f, 0.f, 0.f, 0.f, 0.f, 0.f, 0.f, 0.f, 0.f, 0.f, 0.f, 0.f, 0.f, 0.f}; o[1] = o[0];
        for (int br = 0; br < 3; ++br) {
            const int dil = br == 0 ? 1 : (br == 1 ? 4 : 16), qstep = 16 / dil, nblk = br == 0 ? 20 : (br == 1 ? 8 : 5);
            const int cls = br == 0 ? 0 : (br == 1 ? (c & 3) : c);
            const int I0 = br == 0 ? (T0 + c) : (br == 1 ? (128 * tb + (c >> 2)) : 32 * tb);
            const int ustart = I0 - 128;
            for (int blk = 0; blk < nblk; ++blk) {
                const int ub = ustart + 32 * blk;
                if (ub + 31 < 0) continue;
                int pos = cls + dil * (ub + r); pos = pos < 0 ? 0 : (pos > S - 1 ? S - 1 : pos);
                const bf16* kp = Kb + (size_t)pos * 1024 + hcol + hh * 8;
                f32x16 z = (f32x16){0.f, 0.f, 0.f, 0.f, 0.f, 0.f, 0.f, 0.f, 0.f, 0.f, 0.f, 0.f, 0.f, 0.f, 0.f, 0.f};
                bf16x8 kf[4];
#pragma unroll
                for (int ks = 0; ks < 4; ++ks) kf[ks] = *(const bf16x8*)(kp + ks * 16);
                u32x4 vr[4];
#pragma unroll
                for (int i = 0; i < 4; ++i) { int p2 = cls + dil * (ub + (lane >> 3) + 8 * i); p2 = p2 < 0 ? 0 : (p2 > S - 1 ? S - 1 : p2);
                    vr[i] = *(const u32x4*)(Vb + (size_t)p2 * 1024 + hcol + (lane & 7) * 8); }
#pragma unroll
                for (int ks = 0; ks < 4; ++ks) z = MFMA32(kf[ks], qf[ks], z);
                asm volatile("s_waitcnt lgkmcnt(0)" ::: "memory");
#pragma unroll
                for (int i = 0; i < 4; ++i) *(LAS u32x4*)(vst + ((lane >> 3) + 8 * i) * VP + (lane & 7) * 16) = vr[i];
                asm volatile("s_waitcnt lgkmcnt(0)" ::: "memory");
                unsigned vm = 0u;
#pragma unroll
                for (int i = 0; i < 16; ++i) { const int kk = crow(i, hh), dl = 128 + qstep * r - 32 * blk - kk; vm |= (dl >= 0 && dl <= 128 && (ub + kk) >= 0) ? (1u << i) : 0u; }
                LAS const unsigned char* vp = vst + (4 * hh + ((lane & 15) >> 2)) * VP + (((lane >> 4) & 1) * 16 + (lane & 3) * 4) * 2;
                softmax_block(z, vm, m, l, o, wsf, vp, VP, r, hh);
            }
        }
        FINISH_STORE(T0 + c + 16 * qi);
    }
}

__device__ __forceinline__ void sb_unit(LAS unsigned char* lds, const bf16* Qb, const bf16* Kb, const bf16* Vb, bf16* Ob, int head, int qb) {
    const int tid = otid(), lane = tid & 63, wid = __builtin_amdgcn_readfirstlane(tid >> 6), r = lane & 31, hh = lane >> 5;
    constexpr int KP = 272, VP = 320, KBY = 64 * KP, VBY = 64 * VP, BUF = KBY + VBY;
    const int qw0 = qb * 256 + wid * 32, hcol = head * 128;
    bf16x8 qf[8];
#pragma unroll
    for (int ks = 0; ks < 8; ++ks) qf[ks] = *(const bf16x8*)(Qb + (size_t)(qw0 + r) * 1024 + hcol + ks * 16 + hh * 8);
    bf16x8 uf[2];
#pragma unroll
    for (int s = 0; s < 2; ++s)
#pragma unroll
        for (int j = 0; j < 8; ++j) { const int k = 16 * s + 8 * (j >> 2) + 4 * hh + (j & 3); uf[s][j] = (k >= r) ? (short)0x3F80 : (short)0; }
    f32x16 o[4];
#pragma unroll
    for (int db = 0; db < 4; ++db) o[db] = (f32x16){0.f, 0.f, 0.f, 0.f, 0.f, 0.f, 0.f, 0.f, 0.f, 0.f, 0.f, 0.f, 0.f, 0.f, 0.f, 0.f};
    float Rc = 0.f;
    const int NT = 4 * qb + 4;
    const int srow = tid >> 4, sc16 = tid & 15;
    u32x4 kreg[2], vreg[2];
#pragma unroll
    for (int i = 0; i < 2; ++i) { const size_t g = (size_t)((NT - 1) * 64 + srow + 32 * i) * 1024 + hcol + sc16 * 8; kreg[i] = *(const u32x4*)(Kb + g); vreg[i] = *(const u32x4*)(Vb + g); }
#pragma unroll
    for (int i = 0; i < 2; ++i) { *(LAS u32x4*)(lds + (srow + 32 * i) * KP + sc16 * 16) = kreg[i]; *(LAS u32x4*)(lds + KBY + (srow + 32 * i) * VP + sc16 * 16) = vreg[i]; }
    __syncthreads();
    int buf = 0;
    for (int kt = NT - 1; kt >= 0; --kt) {
        if (kt > 0) {
#pragma unroll
            for (int i = 0; i < 2; ++i) { const size_t g = (size_t)((kt - 1) * 64 + srow + 32 * i) * 1024 + hcol + sc16 * 8; kreg[i] = *(const u32x4*)(Kb + g); vreg[i] = *(const u32x4*)(Vb + g); }
        }
        const bool wdone = __all(Rc >= 104.0f);
        if (!wdone) {
            LAS const unsigned char* kb_ = lds + buf * BUF; LAS const unsigned char* vb_ = kb_ + KBY;
#pragma unroll
            for (int kbi = 0; kbi < 2; ++kbi) {
                const int kb = 1 - kbi, kb0 = kt * 64 + kb * 32;
                if (kb0 >= qw0 + 31) continue;
                const bool need_mask = (kb0 + 31 >= qw0);
                f32x16 z = (f32x16){0.f, 0.f, 0.f, 0.f, 0.f, 0.f, 0.f, 0.f, 0.f, 0.f, 0.f, 0.f, 0.f, 0.f, 0.f, 0.f};
                LAS const unsigned char* kp = kb_ + (kb * 32 + r) * KP + hh * 16;
#pragma unroll
                for (int ks = 0; ks < 8; ++ks) z = MFMA32(*(LAS const bf16x8*)(kp + ks * 32), qf[ks], z);
                unsigned vm = 0xffffu;
                if (need_mask) { vm = 0u;
#pragma unroll
                    for (int i = 0; i < 16; ++i) vm |= ((kb0 + crow(i, hh)) < (qw0 + r)) ? (1u << i) : 0u; }
                f32x16 sp;
#pragma unroll
                for (int i = 0; i < 16; ++i) { const float zi = z[i]; const float e = __builtin_amdgcn_exp2f(-fabsf(zi) * L2E);
                    const float s_ = fmaxf(zi, 0.f) + LN2 * __builtin_amdgcn_logf(1.0f + e); sp[i] = ((vm >> i) & 1u) ? s_ : 0.f; }
                f32x16 rin = (f32x16){0.f, 0.f, 0.f, 0.f, 0.f, 0.f, 0.f, 0.f, 0.f, 0.f, 0.f, 0.f, 0.f, 0.f, 0.f, 0.f};
                rin = MFMA32(uf[0], pack8<0>(sp), rin);
                rin = MFMA32(uf[1], pack8<1>(sp), rin);
                f32x16 a;
#pragma unroll
                for (int i = 0; i < 16; ++i) { const float ai = __builtin_amdgcn_exp2f((z[i] - rin[i] - Rc) * L2E); a[i] = ((vm >> i) & 1u) ? ai : 0.f; }
                Rc += __shfl(rin[0], r);
                const bf16x8 a0 = pack8<0>(a), a1 = pack8<1>(a);
                LAS const unsigned char* vp = vb_ + (kb * 32 + 4 * hh + ((lane & 15) >> 2)) * VP + (((lane >> 4) & 1) * 16 + (lane & 3) * 4) * 2;
#pragma unroll
                for (int db = 0; db < 4; ++db) {
                    o[db] = MFMA32(a0, vfrag(vp + db * 64, 8 * VP), o[db]);
                    o[db] = MFMA32(a1, vfrag(vp + 16 * VP + db * 64, 8 * VP), o[db]);
                }
            }
        }
        if (kt > 0) { LAS unsigned char* d = lds + (buf ^ 1) * BUF;
#pragma unroll
            for (int i = 0; i < 2; ++i) { *(LAS u32x4*)(d + (srow + 32 * i) * KP + sc16 * 16) = kreg[i]; *(LAS u32x4*)(d + KBY + (srow + 32 * i) * VP + sc16 * 16) = vreg[i]; } }
        LAS unsigned* flg = (LAS unsigned*)(lds + ATT_SCR_OFF + 1024) + (kt & 1) * 8;
        if (lane == 0) flg[wid] = wdone ? 1u : 0u;
        __syncthreads();
        buf ^= 1;
        const u32x4 f0 = *(LAS const u32x4*)flg, f1 = *(LAS const u32x4*)(flg + 4);
        if ((f0.x & f0.y & f0.z & f0.w & f1.x & f1.y & f1.z & f1.w) != 0u) break;
    }
#pragma unroll
    for (int db = 0; db < 4; ++db)
#pragma unroll
        for (int i = 0; i < 16; ++i) Ob[(size_t)(qw0 + crow(i, hh)) * 1024 + hcol + db * 32 + r] = (bf16)(cvtpk(o[db][i], 0.f) & 0xffffu);
    __syncthreads();
}


#ifdef SKIP_MOBA
#define MOBA2(head, p) do {} while (0)
#else
#define MOBA2(head, p) do { for (int e_ = 0; e_ < 2; ++e_) moba_unit(lds, Qb, Kb, Vb, Ob, kl, head, e_ ? (p) : 63 - (p)); } while (0)
#endif
#ifdef SKIP_DIL
#define DIL1(h, t) do {} while (0)
#else
#define DIL1(h, t) dilated_unit(lds, Qb, Kb, Vb, Ob, h, t)
#endif
#ifdef SKIP_SB
#define SB1(h, q) do {} while (0)
#else
#define SB1(h, q) sb_unit(lds, Qb, Kb, Vb, Ob, h, q)
#endif
#ifdef SKIP_GEMM1
#define GEMMCALL1 if (0)
#else
#define GEMMCALL1
#endif
#ifdef SKIP_GEMM2
#define GEMMCALL2 if (0)
#else
#define GEMMCALL2
#endif
#ifdef SKIP_GEMM3
#define GEMMCALL3 if (0)
#else
#define GEMMCALL3
#endif
#ifdef SKIP_GEMM4
#define GEMMCALL4 if (0)
#else
#define GEMMCALL4
#endif
__global__ void __launch_bounds__(512, 2) mega_fwd(Params P) {
    extern __shared__ __attribute__((aligned(16))) unsigned char lds_raw[];
    cg::grid_group grid = cg::this_grid();
    LAS unsigned char* lds = (LAS unsigned char*)lds_raw;
    const int G = gridDim.x, bid = blockIdx.x, NGW = G * 8, NTH = G * 512;
#define TIDS() const int tid = otid(), lane = tid & 63, wid = __builtin_amdgcn_readfirstlane(tid >> 6), gw = bid * 8 + wid, gtid = bid * 512 + tid; (void)lane; (void)gw; (void)gtid; LAS float* scr = (LAS float*)(lds + wid * 8448); (void)scr
#define PTRS() unsigned char* ws = P.ws; asm volatile("" : "+s"(ws)); float* X = P.out; asm volatile("" : "+s"(X)); \
    float* kms = (float*)(ws + WS_KMS); float* cosT = (float*)(ws + WS_COS); float* sinT = (float*)(ws + WS_SIN); \
    bf16* H = (bf16*)(ws + WS_H); bf16* Qb = (bf16*)(ws + WS_Q); bf16* Kb = (bf16*)(ws + WS_K); bf16* Vb = (bf16*)(ws + WS_V); bf16* Ob = (bf16*)(ws + WS_O); \
    bf16* U = (bf16*)(ws + WS_U); bf16* A = (bf16*)(ws + WS_A); \
    (void)kms; (void)cosT; (void)sinT; (void)H; (void)Qb; (void)Kb; (void)Vb; (void)Ob; (void)U; (void)A; (void)X

    { TIDS(); PTRS();
    for (int idx = gtid; idx < S * 32; idx += NTH) {
        const int pos = idx >> 5, i = idx & 31;
        const float inv = 1.0f / powf(10000.0f, (float)(2 * i) / 64.0f);
        const float ang = (float)pos * inv;
        cosT[idx] = cosf(ang); sinT[idx] = sinf(ang);
    }
    for (int idx = gtid; idx < 2 * 64 * 256; idx += NTH) kms[idx] = 0.f;
    for (int idx = gtid; idx < S * D / 8; idx += NTH) {
        const f32x4 a = *((const f32x4*)P.in[0] + 2 * (size_t)idx), b = *((const f32x4*)P.in[0] + 2 * (size_t)idx + 1);
        u32x4 w; w.x = cvtpk(a[0], a[1]); w.y = cvtpk(a[2], a[3]); w.z = cvtpk(b[0], b[1]); w.w = cvtpk(b[2], b[3]);
        *((u32x4*)H + idx) = w;
    }
    for (int it = gw; it < WI_ALL; it += NGW) wconv_layer_item(P, 0, it, scr, lane);
    }
    grid.sync();

#pragma unroll 1
    for (int L = 0; L < DEPTH; ++L) {
        const int ev = !(L & 1);
        {   PTRS(); unsigned char* wb = ws + ((L & 1) ? WS_W1 : WS_W0);
            pg8::Gemm g{H, (const bf16*)(wb + WO_QKV), S, 3072, D}; pg8::StaticOrder SO; SO.init(S, 3072, G, bid);
            EpiQKV E{Qb, cosT, sinT, kms + (size_t)(L >> 1) * 64 * 256, ev};
            GEMMCALL1 pg8::gemm_phase<EpiQKV, pg8::StaticOrder, true, true>(lds, g, SO, E);
        }
        grid.sync();
        {   PTRS();
        if (ev) {
            const float* kl = kms + (size_t)(L >> 1) * 64 * 256;
            if (G == 256) {
                if (bid < 128) { const int head = bid & 3, p = bid >> 2; MOBA2(head, p); }
                else { for (int k = 0; k < 3; ++k) { const int uidx = (bid - 128) + 128 * k; DIL1(4 + uidx % 12, uidx / 12); } }
            } else {
                for (int it = bid; it < 512; it += G) {
                    if (it < 128) { const int head = it & 3, p = it >> 2; MOBA2(head, p); }
                    else { const int uidx = it - 128; DIL1(4 + uidx % 12, uidx / 12); }
                }
            }
        } else {
            for (int it = bid; it < 512; it += G) SB1(it & 7, it >> 3);
        }
        }
        grid.sync();
        {   PTRS(); unsigned char* wb = ws + ((L & 1) ? WS_W1 : WS_W0);
            pg8::Gemm g{Ob, (const bf16*)(wb + WO_O), S, D, D}; pg8::StaticOrder SO; SO.init(S, D, G, bid);
            EpiResid E{(L == 0) ? P.in[0] : X, X};
            GEMMCALL2 pg8::gemm_phase<EpiResid, pg8::StaticOrder, true, true>(lds, g, SO, E);
        }
        grid.sync();
        { TIDS(); PTRS(); for (int row = gw; row < S; row += NGW) ln_row(X + (size_t)row * D, H + (size_t)row * D, P.in[5] + L * D, P.in[6] + L * D, lane); }
        grid.sync();
        {   PTRS(); unsigned char* wb = ws + ((L & 1) ? WS_W1 : WS_W0);
            pg8::Gemm g{H, (const bf16*)(wb + WO_UP), S, F2, D}; pg8::StaticOrder SO; SO.init(S, F2, G, bid);
            pg8::EpiBf16<0> E{U, F2, nullptr, 0, 0, 1.f};
            GEMMCALL3 pg8::gemm_phase<pg8::EpiBf16<0>, pg8::StaticOrder, true, true>(lds, g, SO, E);
        }
        grid.sync();
        {
            TIDS(); PTRS(); const int nconv = 512 * 11, ntot = nconv + (L + 1 < DEPTH ? WI_ALL : 0);
            for (int it = gw; it < ntot; it += NGW) {
                if (it < nconv) conv_item(U, A, P.in[8] + (size_t)L * 3 * F2, P.in[9] + (size_t)L * F2, it, lane);
                else wconv_layer_item(P, L + 1, it - nconv, scr, lane);
            }
        }
        grid.sync();
        {   PTRS(); unsigned char* wb = ws + ((L & 1) ? WS_W1 : WS_W0);
            pg8::Gemm g{A, (const bf16*)(wb + WO_DN), S, D, F}; pg8::StaticOrder SO; SO.init(S, D, G, bid);
            EpiResid E{X, X};
            GEMMCALL4 pg8::gemm_phase<EpiResid, pg8::StaticOrder, true, true>(lds, g, SO, E);
        }
        grid.sync();
        { TIDS(); PTRS(); for (int row = gw; row < S; row += NGW) ln_row(X + (size_t)row * D, H + (size_t)row * D, P.in[11] + L * D, P.in[12] + L * D, lane); }
        grid.sync();
    }
}

extern "C" void kernel_launch(void* const* d_in, const int* in_sizes, int n_in, void* d_out, int out_size, void* d_ws, size_t ws_size, hipStream_t stream) {
    static int grid = 0;
    if (grid == 0) {
        if (n_in != 13 || in_sizes[0] != S * D || out_size != S * D || ws_size < WS_END) {
            fprintf(stderr, "kernel_launch: unexpected shapes (n_in %d, in0 %d, out %d, ws %zu < %zu)\n", n_in, n_in > 0 ? in_sizes[0] : -1, out_size, ws_size, (size_t)WS_END); grid = -1; return; }
        int dev = 0, cus = 0, per_cu = 0;
        hipGetDevice(&dev); hipDeviceGetAttribute(&cus, hipDeviceAttributeMultiprocessorCount, dev);
        if (hipFuncSetAttribute((const void*)mega_fwd, hipFuncAttributeMaxDynamicSharedMemorySize, LDS_BYTES) != hipSuccess) { fprintf(stderr, "kernel_launch: hipFuncSetAttribute failed\n"); grid = -1; return; }
        if (hipOccupancyMaxActiveBlocksPerMultiprocessor(&per_cu, (const void*)mega_fwd, 512, LDS_BYTES) != hipSuccess || per_cu < 1) { fprintf(stderr, "kernel_launch: occupancy query says %d\n", per_cu); per_cu = 1; }
        (void)hipGetLastError();
        grid = cus * 1;
    }
    if (grid < 0) return;
    Params p{};
    for (int i = 0; i < 13; ++i) p.in[i] = (const float*)d_in[i];
    p.out = (float*)d_out; p.ws = (unsigned char*)d_ws;
    void* args[] = {&p};
    hipError_t e = hipLaunchCooperativeKernel((const void*)mega_fwd, dim3(grid), dim3(512), args, LDS_BYTES, stream);
    if (e != hipSuccess) fprintf(stderr, "cooperative launch failed: %s (grid %d)\n", hipGetErrorString(e), grid);
}
```

```cpp
#include <hip/hip_runtime.h>
#include <hip/hip_cooperative_groups.h>
#include <cstdio>
#include <cstdint>
namespace cg = cooperative_groups;
#include <cmath>
namespace pg8 {
#define PG8_LAS __attribute__((address_space(3)))
typedef unsigned short bf16_t;
typedef short bf16x8 __attribute__((ext_vector_type(8)));
typedef float f32x4 __attribute__((ext_vector_type(4)));
typedef unsigned u32x4 __attribute__((ext_vector_type(4)));
constexpr int BM = 256, BK = 64, HALF = 128, HTB = HALF * BK * 2  , STAGE_BYTES = 8 * HTB, NXCD = 8, WGM = 8;

__host__ __device__ __forceinline__ int lds_byte(int r, int c) { const int st = (r >> 4) * 2 + (c >> 5), rr = r & 15, cc = c & 31, ob = rr * 64 + cc * 2; return st * 1024 + (ob ^ (((ob >> 9) & 1) << 5)); }
__host__ __device__ __forceinline__ void stage_rc(int b, int& R, int& C) { const int st = b / 1024, sb = b % 1024, swz = sb ^ (((sb >> 9) & 1) << 5); R = (st >> 1) * 16 + swz / 64; C = (st & 1) * 32 + (swz % 64) / 2; }
__host__ __device__ __forceinline__ int perm32(int rho) { const int n = rho >> 4, i = rho & 15; return 8 * (i >> 2) + 4 * n + (i & 3); }

struct Unit { int pm, pn; };
struct Gemm { const bf16_t* A; const bf16_t* Bt; int M, N, K; };

struct StaticOrder {
    int nM, nN, nwg, G, c;
    __host__ __device__ void init(int M, int N, int G_, int c_) { nM = M / BM; nN = N / BM; nwg = nM * nN; G = G_; c = c_; }
    __host__ __device__ bool next(int i, Unit& u) const {
        const long L = (long)i * G + c; if (L >= nwg) return false;
        int wgid = (int)L; { const int q = nwg / NXCD, r = nwg % NXCD, xcd = wgid % NXCD, off = wgid / NXCD; wgid = (xcd < r ? xcd * (q + 1) : r * (q + 1) + (xcd - r) * q) + off; }
        const int nig = WGM * nN, gid = wgid / nig, fm = gid * WGM, gsz = (nM - fm) < WGM ? (nM - fm) : WGM;
        u.pm = fm + ((wgid % nig) % gsz); u.pn = (wgid % nig) / gsz; return true;
    }
    __device__ __forceinline__ void a_ready(const Unit&) const {}
    __device__ __forceinline__ void done(const Unit&) const {}
};

__device__ __forceinline__ unsigned cvt_pk_bf16(float lo, float hi) { unsigned r; asm volatile("v_cvt_pk_bf16_f32 %0, %1, %2" : "=v"(r) : "v"(lo), "v"(hi)); return r; }
typedef float f32x2 __attribute__((ext_vector_type(2)));
__device__ __forceinline__ f32x2 gelu_pk(f32x2 v) {
    const f32x2 av = __builtin_elementwise_abs(v), d = av * 0.2316418882f + 1.0f;
    f32x2 t; t.x = __builtin_amdgcn_rcpf(d.x); t.y = __builtin_amdgcn_rcpf(d.y);
    f32x2 q = t * 0.5307027145f + (-0.7265760135f); q = q * t + 0.7107068705f; q = q * t + (-0.142248368f); q = q * t + 0.127414796f; q = q * t;
    const f32x2 s = (v * v) * (-0.72134752044f);
    f32x2 e; e.x = __builtin_amdgcn_exp2f(s.x); e.y = __builtin_amdgcn_exp2f(s.y);
    const f32x2 m = v * (q * e), r = v - m;
    f32x2 o; o.x = v.x < 0.f ? m.x : r.x; o.y = v.y < 0.f ? m.y : r.y; return o;
}

template <int ACT  > struct EpiBf16 {
    static constexpr bool PERM = true, AFTER_DRAIN = false; static_assert(ACT == 0 || ACT == 1, "EpiBf16: ACT is 0 (none) or 1 (gelu_pk)");
    bf16_t* O; int ldc; const float* bias; int split_cols; size_t split_stride; float scale0;
    __device__ __forceinline__ void operator()(const f32x4 (&acc)[2][2][4][2], const Unit& u, int wr, int wc, int fr, int fq) const {
        const int row0 = u.pm * BM + wr * 64 + fr; int colt = u.pn * BM; bf16_t* base = O;
        float sc = 1.f; if (split_cols) { const int t = colt / split_cols; base += (size_t)t * split_stride; colt -= t * split_cols; if (t == 0) sc = scale0; }
        const int col0 = colt + wc * 32 + 8 * fq, bcol0 = u.pn * BM + wc * 32 + 8 * fq;
        f32x4 bv[2][2];
#pragma unroll
        for (int bj = 0; bj < 2; ++bj)
#pragma unroll
            for (int n = 0; n < 2; ++n) bv[bj][n] = bias ? *(const f32x4*)(bias + bcol0 + bj * HALF + 4 * n) : (f32x4){0.f, 0.f, 0.f, 0.f};
#pragma unroll
        for (int ai = 0; ai < 2; ++ai)
#pragma unroll
            for (int m = 0; m < 4; ++m) { bf16_t* rowp = base + (size_t)(row0 + ai * HALF + m * 16) * ldc + col0;
#pragma unroll
                for (int bj = 0; bj < 2; ++bj) { f32x4 v0 = acc[ai][bj][m][0] + bv[bj][0], v1 = acc[ai][bj][m][1] + bv[bj][1];
                    if (ACT == 1) { f32x2 a = gelu_pk((f32x2){v0[0], v0[1]}), b = gelu_pk((f32x2){v0[2], v0[3]}), c = gelu_pk((f32x2){v1[0], v1[1]}), d = gelu_pk((f32x2){v1[2], v1[3]});
                        v0 = (f32x4){a.x, a.y, b.x, b.y}; v1 = (f32x4){c.x, c.y, d.x, d.y}; }
                    v0 = v0 * sc; v1 = v1 * sc; u32x4 w; w.x = cvt_pk_bf16(v0[0], v0[1]); w.y = cvt_pk_bf16(v0[2], v0[3]); w.z = cvt_pk_bf16(v1[0], v1[1]); w.w = cvt_pk_bf16(v1[2], v1[3]);
                    *(u32x4*)(rowp + bj * HALF) = w; } }
    }
};

struct PanelStats {
    unsigned* xbuf;
    unsigned* cnt;
    unsigned* tmo;
    int ntn; float eps;
    unsigned code;
    __device__ __forceinline__ bool run(const f32x4 (&v)[2][2][4][2], const Unit& u, int wr, int wc, int fr, int fq, PG8_LAS unsigned char* lds, int wid, int lane) const {
        typedef float f32x2v __attribute__((ext_vector_type(2)));
        PG8_LAS f32x2v* P = (PG8_LAS f32x2v*)lds;
        PG8_LAS f32x2v* S = (PG8_LAS f32x2v*)(lds + 8192);
        PG8_LAS unsigned* flag = (PG8_LAS unsigned*)(lds + 8192 + 2048);
#pragma unroll
        for (int ai = 0; ai < 2; ++ai)
#pragma unroll
            for (int m = 0; m < 4; ++m) {
                float s = 0.f;
#pragma unroll
                for (int bj = 0; bj < 2; ++bj)
#pragma unroll
                    for (int n = 0; n < 2; ++n) { const f32x4 x = v[ai][bj][m][n]; s += (x[0] + x[1]) + (x[2] + x[3]); }
                s += __shfl_xor(s, 16); s += __shfl_xor(s, 32);
                const float mw = s * (1.0f / 64.0f); float q = 0.f;
#pragma unroll
                for (int bj = 0; bj < 2; ++bj)
#pragma unroll
                    for (int n = 0; n < 2; ++n) { const f32x4 d = v[ai][bj][m][n] - mw; q += (d[0] * d[0] + d[1] * d[1]) + (d[2] * d[2] + d[3] * d[3]); }
                q += __shfl_xor(q, 16); q += __shfl_xor(q, 32);
                if (fq == 0) P[(ai * HALF + wr * 64 + m * 16 + fr) * 4 + wc] = (f32x2v){mw, q};
            }
        asm volatile("s_waitcnt lgkmcnt(0)" ::: "memory"); __builtin_amdgcn_s_barrier(); asm volatile("" ::: "memory");
#if defined(BROKEN_EXCHANGE_NO_WAIT)
#warning BROKEN CONTROL BUILD: the row-statistics exchange does not wait; results are wrong by design
        if (blockIdx.x >= 64) { const long long t0_ = clock64(); while (clock64() - t0_ < 60000) __builtin_amdgcn_s_sleep(8); }
#endif
        const int row = wid * 32 + (lane & 31);
        if (lane < 32) {
            const f32x2v a = P[row * 4 + 0], b = P[row * 4 + 1], c = P[row * 4 + 2], d = P[row * 4 + 3];
            const float mt = (a.x + b.x + c.x + d.x) * 0.25f;
            const float da = a.x - mt, db = b.x - mt, dc = c.x - mt, dd = d.x - mt;
            const float m2 = (a.y + b.y) + (c.y + d.y) + 64.0f * ((da * da + db * db) + (dc * dc + dd * dd));
            unsigned long long* slot = (unsigned long long*)xbuf + ((size_t)(u.pm * BM + row) * 4 + u.pn);
            __hip_atomic_store(slot, ((unsigned long long)__float_as_uint(m2) << 32) | __float_as_uint(mt), __ATOMIC_RELAXED, __HIP_MEMORY_SCOPE_AGENT);
        }
        asm volatile("s_waitcnt vmcnt(0)" ::: "memory");
        if (lane == 0) __hip_atomic_fetch_add(cnt + 64 * u.pm, 1u, __ATOMIC_RELAXED, __HIP_MEMORY_SCOPE_AGENT);
        if (wid == 0) {
            bool dead = false; const unsigned long long t0 = __builtin_amdgcn_s_memrealtime(); const unsigned want = 8u * (unsigned)ntn;
            for (;;) {
#if defined(BROKEN_EXCHANGE_NO_WAIT)
                break;
#endif
                if ((unsigned)__builtin_amdgcn_readfirstlane(__hip_atomic_load(cnt + 64 * u.pm, __ATOMIC_RELAXED, __HIP_MEMORY_SCOPE_AGENT)) >= want) break;
                if (__builtin_amdgcn_s_memrealtime() - t0 > 2000000ull) {
                    if (lane == 0) { unsigned expect = 0u; __hip_atomic_compare_exchange_strong(tmo + 1, &expect, code | (unsigned)(u.pm & 0xff), __ATOMIC_RELAXED, __ATOMIC_RELAXED, __HIP_MEMORY_SCOPE_AGENT);
                                     __hip_atomic_store(tmo, 1u, __ATOMIC_RELAXED, __HIP_MEMORY_SCOPE_AGENT); }
                    dead = true; break; }
                __builtin_amdgcn_s_sleep(2);
            }
            __builtin_amdgcn_fence(__ATOMIC_ACQUIRE, "agent");
            if (lane == 0) flag[0] = dead ? 1u : 0u;
        }
        asm volatile("s_waitcnt vmcnt(0) lgkmcnt(0)" ::: "memory"); __builtin_amdgcn_s_barrier(); asm volatile("" ::: "memory");
        const bool bad = flag[0] != 0u;
        if (lane < 32) {
            const unsigned long long* slot = (const unsigned long long*)xbuf + (size_t)(u.pm * BM + row) * 4; float mt[4], m2[4]; float ms = 0.f;
#pragma unroll
            for (int t = 0; t < 4; ++t) { if (t < ntn) { const unsigned long long w = __hip_atomic_load(slot + t, __ATOMIC_RELAXED, __HIP_MEMORY_SCOPE_AGENT); mt[t] = __uint_as_float((unsigned)w); m2[t] = __uint_as_float((unsigned)(w >> 32)); } else { mt[t] = 0.f; m2[t] = 0.f; } ms += mt[t]; }
            const float mean = ms / (float)ntn; float q = 0.f;
#pragma unroll
            for (int t = 0; t < 4; ++t) if (t < ntn) { const float dm = mt[t] - mean; q += m2[t] + 256.0f * dm * dm; }
            S[row] = (f32x2v){mean, 1.0f / sqrtf(q / (256.0f * (float)ntn) + eps)};
        }
        asm volatile("s_waitcnt lgkmcnt(0)" ::: "memory"); __builtin_amdgcn_s_barrier(); asm volatile("" ::: "memory");
        return bad;
    }
};
struct EpiLnRes {
    static constexpr bool PERM = false, AFTER_DRAIN = true;
    const float* base; float* out; int ldc; const float* bias; PanelStats st; unsigned poison;
    __device__ __forceinline__ void fused(f32x4 (&acc)[2][2][4][2], const Unit& u, int wr, int wc, int fr, int fq, PG8_LAS unsigned char* lds, int wid, int lane) const {
        typedef float f32x2v __attribute__((ext_vector_type(2)));
        const PG8_LAS f32x2v* S = (const PG8_LAS f32x2v*)(lds + 8192);
        const int col0 = u.pn * BM + wc * 32 + 4 * fq;
#pragma unroll
        for (int bj = 0; bj < 2; ++bj)
#pragma unroll
            for (int n = 0; n < 2; ++n) { const f32x4 bv = bias ? *(const f32x4*)(bias + col0 + bj * HALF + n * 16) : (f32x4){0.f, 0.f, 0.f, 0.f};
#pragma unroll
                for (int ai = 0; ai < 2; ++ai)
#pragma unroll
                    for (int m = 0; m < 4; ++m) acc[ai][bj][m][n] += bv; }
        f32x4 pre[4][2][2];
#pragma unroll
        for (int m = 0; m < 4; ++m) { const size_t off = (size_t)(u.pm * BM + wr * 64 + m * 16 + fr) * ldc + col0;
#pragma unroll
            for (int bj = 0; bj < 2; ++bj)
#pragma unroll
                for (int n = 0; n < 2; ++n) pre[m][bj][n] = *(const f32x4*)(base + off + bj * HALF + n * 16); }
        const bool bad = st.run(acc, u, wr, wc, fr, fq, lds, wid, lane) || poison != 0u;
        const float qnan = __builtin_nanf("");
#pragma unroll
        for (int ai = 0; ai < 2; ++ai)
#pragma unroll
            for (int m = 0; m < 4; ++m) { const int r = ai * HALF + wr * 64 + m * 16 + fr; const f32x2v sr = S[r]; const size_t off = (size_t)(u.pm * BM + r) * ldc + col0;
#pragma unroll
                for (int bj = 0; bj < 2; ++bj)
#pragma unroll
                    for (int n = 0; n < 2; ++n) { const f32x4 bs = ai == 0 ? pre[m][bj][n] : *(const f32x4*)(base + off + bj * HALF + n * 16); f32x4 o = bs + (acc[ai][bj][m][n] - sr.x) * sr.y;
                        if (bad) o = (f32x4){qnan, qnan, qnan, qnan}; *(f32x4*)(out + off + bj * HALF + n * 16) = o; }
                if (m & 1) asm volatile("" ::: "memory"); }
    }
};
struct EpiLnResLn {
    static constexpr bool PERM = false, AFTER_DRAIN = true;
    const float* base; float* out; bf16_t* xn; int ldc; const float* bias; PanelStats st1, st2; unsigned poison;
    __device__ __forceinline__ void fused(f32x4 (&acc)[2][2][4][2], const Unit& u, int wr, int wc, int fr, int fq, PG8_LAS unsigned char* lds, int wid, int lane) const {
        typedef float f32x2v __attribute__((ext_vector_type(2))); typedef unsigned u32x2v __attribute__((ext_vector_type(2)));
        const PG8_LAS f32x2v* S = (const PG8_LAS f32x2v*)(lds + 8192);
        const int col0 = u.pn * BM + wc * 32 + 4 * fq;
#pragma unroll
        for (int bj = 0; bj < 2; ++bj)
#pragma unroll
            for (int n = 0; n < 2; ++n) { const f32x4 bv = bias ? *(const f32x4*)(bias + col0 + bj * HALF + n * 16) : (f32x4){0.f, 0.f, 0.f, 0.f};
#pragma unroll
                for (int ai = 0; ai < 2; ++ai)
#pragma unroll
                    for (int m = 0; m < 4; ++m) acc[ai][bj][m][n] += bv; }
        bool bad = st1.run(acc, u, wr, wc, fr, fq, lds, wid, lane) || poison != 0u;
        const float qnan = __builtin_nanf("");
#pragma unroll
        for (int ai = 0; ai < 2; ++ai)
#pragma unroll
            for (int m = 0; m < 4; ++m) { const int r = ai * HALF + wr * 64 + m * 16 + fr; const f32x2v sr = S[r]; const size_t off = (size_t)(u.pm * BM + r) * ldc + col0;
#pragma unroll
                for (int bj = 0; bj < 2; ++bj)
#pragma unroll
                    for (int n = 0; n < 2; ++n) { const f32x4 bs = *(const f32x4*)(base + off + bj * HALF + n * 16); acc[ai][bj][m][n] = bs + (acc[ai][bj][m][n] - sr.x) * sr.y; }
                asm volatile("" : "+v"(acc[ai][0][m][0]), "+v"(acc[ai][0][m][1]), "+v"(acc[ai][1][m][0]), "+v"(acc[ai][1][m][1]));
                if (m & 1) asm volatile("" ::: "memory"); }
        const bool bad1 = bad;
        bad = st2.run(acc, u, wr, wc, fr, fq, lds, wid, lane) || bad;
#pragma unroll
        for (int ai = 0; ai < 2; ++ai)
#pragma unroll
            for (int m = 0; m < 4; ++m) { const int r = ai * HALF + wr * 64 + m * 16 + fr; const f32x2v sr = S[r]; const size_t off = (size_t)(u.pm * BM + r) * ldc + col0;
#pragma unroll
                for (int bj = 0; bj < 2; ++bj)
#pragma unroll
                    for (int n = 0; n < 2; ++n) { const f32x4 x1 = acc[ai][bj][m][n]; *(f32x4*)(out + off + bj * HALF + n * 16) = bad1 ? (f32x4){qnan, qnan, qnan, qnan} : x1;
                        const f32x4 o = (x1 - sr.x) * sr.y; u32x2v w; w.x = cvt_pk_bf16(o[0], o[1]); w.y = cvt_pk_bf16(o[2], o[3]);
                        if (bad) { w.x = 0x7fc07fc0u; w.y = 0x7fc07fc0u; } *(u32x2v*)(xn + off + bj * HALF + n * 16) = w; }
                asm volatile("" ::: "memory"); }
    }
};

template <class Epi, class Sched, bool ALIGN_EPI = false, bool SP2 = false>
__device__ __forceinline__ void gemm_phase(PG8_LAS unsigned char* lds, const Gemm g, const Sched& S, const Epi& E) {
    int tid_ = threadIdx.x; asm volatile("" : "+v"(tid_)); const int tid = tid_, wid = __builtin_amdgcn_readfirstlane(tid >> 6), lane = tid & 63, wr = wid >> 2, wc = wid & 3, fr = lane & 15, fq = lane >> 4;
    const int K = g.K, nt = K / BK;
    unsigned voffA[2], voffB[2];
#pragma unroll
    for (int i = 0; i < 2; ++i) { int R, C; stage_rc(tid * 16 + i * 8192, R, C); const int Rb = Epi::PERM ? ((R & ~31) + perm32(R & 31)) : R;
        voffA[i] = (unsigned)(R * K + C) * 2u; voffB[i] = (unsigned)(Rb * K + C) * 2u; }
    const size_t kstep = (size_t)(BK * 2);
    const size_t hstep = (size_t)HALF * K * 2;
    const size_t tstep = 2 * hstep;
    const unsigned ldsw = (unsigned)wid * 1024u;
    const int aoff = lds_byte(wr * 64 + fr, fq * 8), boff = lds_byte(wc * 32 + fr, fq * 8);
#define PG8_SA(b, h) (((b) * 2 + (h)) * HTB)
#define PG8_SB(b, h) ((4 + (b) * 2 + (h)) * HTB)
#define PG8_STAGE(bufoff, gbase, voff) do { _Pragma("unroll") for (int _i = 0; _i < 2; ++_i) \
        __builtin_amdgcn_global_load_lds((const unsigned*)((const char*)(gbase) + (voff)[_i]), (PG8_LAS unsigned*)(lds + (bufoff) + ldsw + _i * 8192), 16, 0, 0); } while (0)
#define PG8_LDA(dst, b, h) do { _Pragma("unroll") for (int m = 0; m < 4; ++m) _Pragma("unroll") for (int k = 0; k < 2; ++k) dst[m][k] = *(const PG8_LAS bf16x8*)(lds + PG8_SA(b, h) + aoff + m * 2048 + k * 1024); } while (0)
#define PG8_LDB(dst, b, h) do { _Pragma("unroll") for (int n = 0; n < 2; ++n) _Pragma("unroll") for (int k = 0; k < 2; ++k) dst[n][k] = *(const PG8_LAS bf16x8*)(lds + PG8_SB(b, h) + boff + n * 2048 + k * 1024); } while (0)
#define PG8_MMA(ai, bj, At, Bt) do { __builtin_amdgcn_s_setprio(1); _Pragma("unroll") for (int m = 0; m < 4; ++m) _Pragma("unroll") for (int n = 0; n < 2; ++n) _Pragma("unroll") for (int k = 0; k < 2; ++k) \
        acc[ai][bj][m][n] = __builtin_amdgcn_mfma_f32_16x16x32_bf16(Bt[n][k], At[m][k], acc[ai][bj][m][n], 0, 0, 0); __builtin_amdgcn_s_setprio(0); } while (0)
#define PG8_WAIT_V(n) asm volatile("s_waitcnt vmcnt(" #n ")" ::: "memory")
#define PG8_WAIT_L(n) asm volatile("s_waitcnt lgkmcnt(" #n ")" ::: "memory")
#define PG8_BAR __builtin_amdgcn_s_barrier()
#define PG8_SCHED __builtin_amdgcn_sched_barrier(0)
    Unit cur, nxt; int ui = 0;
    if (!S.next(0, cur)) return;
    f32x4 acc[2][2][4][2];
#pragma unroll
    for (int a = 0; a < 2; ++a)
#pragma unroll
        for (int b = 0; b < 2; ++b)
#pragma unroll
            for (int m = 0; m < 4; ++m)
#pragma unroll
                for (int n = 0; n < 2; ++n) acc[a][b][m][n] = (f32x4){0.f, 0.f, 0.f, 0.f};
    bf16x8 At[4][2], B0[2][2], B1[2][2];
    const char* cA = (const char*)g.A + (size_t)cur.pm * tstep; const char* cB = (const char*)g.Bt + (size_t)cur.pn * tstep;
    S.a_ready(cur);
    if constexpr (SP2) {
        PG8_STAGE(PG8_SB(0, 0), cB, voffB); PG8_STAGE(PG8_SB(0, 1), cB + hstep, voffB); PG8_STAGE(PG8_SA(0, 0), cA, voffA); PG8_STAGE(PG8_SA(0, 1), cA + hstep, voffA);
        if (wr == 1) PG8_BAR;
        PG8_WAIT_V(2); PG8_BAR;
        PG8_STAGE(PG8_SB(1, 0), cB + kstep, voffB); PG8_STAGE(PG8_SA(1, 0), cA + kstep, voffA); PG8_STAGE(PG8_SB(1, 1), cB + hstep + kstep, voffB);
        PG8_WAIT_V(6); PG8_BAR;
    } else {
        PG8_STAGE(PG8_SB(0, 0), cB, voffB); PG8_STAGE(PG8_SA(0, 0), cA, voffA); PG8_STAGE(PG8_SB(0, 1), cB + hstep, voffB); PG8_STAGE(PG8_SA(0, 1), cA + hstep, voffA);
        if (wr == 1) PG8_BAR;
        PG8_WAIT_V(4); PG8_BAR;
        PG8_STAGE(PG8_SB(1, 0), cB + kstep, voffB); PG8_STAGE(PG8_SA(1, 0), cA + kstep, voffA); PG8_STAGE(PG8_SB(1, 1), cB + hstep + kstep, voffB);
        PG8_WAIT_V(6); PG8_BAR;
    }
    for (;;) {
        const bool has_next = S.next(ui + 1, nxt);
        const char* nA = has_next ? (const char*)g.A + (size_t)nxt.pm * tstep : cA; const char* nB = has_next ? (const char*)g.Bt + (size_t)nxt.pn * tstep : cB;
        for (int t = 0; t < nt; t += 2) {
            const bool last = (t == nt - 2);
            const char* a1 = cA + (size_t)(t + 1) * kstep;
            const char* a2 = last ? nA : cA + (size_t)(t + 2) * kstep; const char* b2 = last ? nB : cB + (size_t)(t + 2) * kstep;
            const char* a3 = a2 + kstep; const char* b3 = b2 + kstep;
            if (last && has_next) S.a_ready(nxt);
            if constexpr (SP2) {
            PG8_LDB(B0, 0, 0); PG8_LDB(B1, 0, 1); PG8_SCHED; PG8_LDA(At, 0, 0); PG8_STAGE(PG8_SA(1, 1), a1 + hstep, voffA);
            PG8_WAIT_V(8); PG8_WAIT_L(0); PG8_BAR; PG8_MMA(0, 0, At, B0); PG8_MMA(0, 1, At, B1); PG8_BAR; PG8_SCHED;
            PG8_LDA(At, 0, 1); PG8_STAGE(PG8_SB(0, 0), b2, voffB); PG8_STAGE(PG8_SB(0, 1), b2 + hstep, voffB); PG8_STAGE(PG8_SA(0, 0), a2, voffA);
            PG8_WAIT_V(8); PG8_WAIT_L(0); PG8_BAR; PG8_MMA(1, 0, At, B0); PG8_MMA(1, 1, At, B1); PG8_BAR; PG8_SCHED;
            PG8_LDB(B0, 1, 0); PG8_LDB(B1, 1, 1); PG8_SCHED; PG8_LDA(At, 1, 0); PG8_STAGE(PG8_SA(0, 1), a2 + hstep, voffA);
            PG8_WAIT_V(8); PG8_WAIT_L(0); PG8_BAR; PG8_MMA(0, 0, At, B0); PG8_MMA(0, 1, At, B1); PG8_BAR; PG8_SCHED;
            PG8_LDA(At, 1, 1); PG8_STAGE(PG8_SB(1, 0), b3, voffB); PG8_STAGE(PG8_SB(1, 1), b3 + hstep, voffB); PG8_STAGE(PG8_SA(1, 0), a3, voffA);
            PG8_WAIT_V(8); PG8_WAIT_L(0); PG8_BAR; PG8_MMA(1, 0, At, B0); PG8_MMA(1, 1, At, B1); PG8_BAR; PG8_SCHED;
            } else {
            PG8_LDB(B0, 0, 0); PG8_SCHED; PG8_LDA(At, 0, 0); PG8_STAGE(PG8_SA(1, 1), a1 + hstep, voffA);
            PG8_WAIT_L(8); PG8_BAR; PG8_WAIT_L(0); PG8_MMA(0, 0, At, B0); PG8_BAR; PG8_SCHED;
            PG8_LDB(B1, 0, 1); PG8_STAGE(PG8_SB(0, 0), b2, voffB);
            PG8_BAR; PG8_WAIT_L(0); PG8_MMA(0, 1, At, B1); PG8_BAR;
            PG8_LDA(At, 0, 1); PG8_STAGE(PG8_SA(0, 0), a2, voffA);
            PG8_BAR; PG8_WAIT_L(0); PG8_MMA(1, 0, At, B0); PG8_BAR; PG8_SCHED;
            PG8_STAGE(PG8_SB(0, 1), b2 + hstep, voffB);
            PG8_WAIT_V(6); PG8_BAR; PG8_MMA(1, 1, At, B1); PG8_BAR;
            PG8_LDB(B0, 1, 0); PG8_SCHED; PG8_LDA(At, 1, 0); PG8_STAGE(PG8_SA(0, 1), a2 + hstep, voffA);
            PG8_WAIT_L(8); PG8_BAR; PG8_WAIT_L(0); PG8_MMA(0, 0, At, B0); PG8_BAR; PG8_SCHED;
            PG8_LDB(B1, 1, 1); PG8_STAGE(PG8_SB(1, 0), b3, voffB);
            PG8_BAR; PG8_WAIT_L(0); PG8_MMA(0, 1, At, B1); PG8_BAR;
            PG8_LDA(At, 1, 1); PG8_STAGE(PG8_SA(1, 0), a3, voffA);
            PG8_BAR; PG8_WAIT_L(0); PG8_MMA(1, 0, At, B0); PG8_BAR; PG8_SCHED;
            PG8_STAGE(PG8_SB(1, 1), b3 + hstep, voffB);
            PG8_WAIT_V(6); PG8_BAR; PG8_MMA(1, 1, At, B1); PG8_BAR;
            }
        }
        if constexpr (ALIGN_EPI) { if (wr == 0) PG8_BAR; }
        if constexpr (!Epi::AFTER_DRAIN) { E(acc, cur, wr, wc, fr, fq); S.done(cur); }
        if (!has_next) break;
#pragma unroll
        for (int a = 0; a < 2; ++a)
#pragma unroll
            for (int b = 0; b < 2; ++b)
#pragma unroll
                for (int m = 0; m < 4; ++m)
#pragma unroll
                    for (int n = 0; n < 2; ++n) acc[a][b][m][n] = (f32x4){0.f, 0.f, 0.f, 0.f};
        cur = nxt; cA = nA; cB = nB; ++ui;
        if constexpr (ALIGN_EPI) { if (wr == 1) PG8_BAR; }
    }
    PG8_WAIT_V(0);
    if constexpr (!ALIGN_EPI) { if (wr == 0) PG8_BAR; }
    PG8_BAR;
    if constexpr (Epi::AFTER_DRAIN) { E.fused(acc, cur, wr, wc, fr, fq, lds, wid, lane); S.done(cur); }
#undef PG8_SA
#undef PG8_SB
#undef PG8_STAGE
#undef PG8_LDA
#undef PG8_LDB
#undef PG8_MMA
#undef PG8_WAIT_V
#undef PG8_WAIT_L
#undef PG8_BAR
#undef PG8_SCHED
}
}

#define LAS __attribute__((address_space(3)))
typedef unsigned short bf16;
typedef float f32x4 __attribute__((ext_vector_type(4)));
typedef float f32x16 __attribute__((ext_vector_type(16)));
typedef short bf16x8 __attribute__((ext_vector_type(8)));
typedef short s16x4 __attribute__((ext_vector_type(4)));
typedef unsigned u32x4 __attribute__((ext_vector_type(4)));
typedef unsigned u32x2 __attribute__((ext_vector_type(2)));

constexpr int S = 16384, D = 1024, F = 2816, F2 = 5632, DEPTH = 4;
constexpr float LN_EPS = 1e-5f;
constexpr float ALPHA = 1.6817928305074290f;
constexpr float L2E = 1.4426950408889634f, LN2 = 0.6931471805599453f;
constexpr size_t MiB = 1u << 20;
constexpr size_t WS_KMS = 0;
constexpr size_t WS_BAR = 512 * 1024;
constexpr size_t WS_COS = 1 * MiB, WS_SIN = 3 * MiB;
constexpr size_t WS_W0 = 5 * MiB, WS_W1 = 30 * MiB;
constexpr size_t WO_QKV = 0, WO_O = 6 * MiB, WO_UP = 8 * MiB, WO_DN = 19 * MiB;
constexpr size_t WS_H = 55 * MiB;
constexpr size_t WS_Q = 87 * MiB, WS_K = 119 * MiB, WS_V = 151 * MiB, WS_O = 183 * MiB;
constexpr size_t WS_U = 87 * MiB;
constexpr size_t WS_A = 263 * MiB;
constexpr size_t WS_END = 351 * MiB;
static_assert(WS_K - WS_Q == 32 * MiB && WS_V - WS_K == 32 * MiB, "EpiQKV strides");
constexpr int LDS_BYTES = 147456;
constexpr int ATT_SCR_OFF = 136 * 1024;

__device__ __forceinline__ unsigned cvtpk(float lo, float hi) {
    typedef float f2 __attribute__((ext_vector_type(2))); typedef __bf16 b2 __attribute__((ext_vector_type(2)));
    f2 v = {lo, hi}; b2 b = __builtin_convertvector(v, b2); return __builtin_bit_cast(unsigned, b);
}
__device__ __forceinline__ float bf2f(unsigned short h) { return __uint_as_float(((unsigned)h) << 16); }
__device__ __forceinline__ int crow(int r, int hi) { return (r & 3) + 8 * (r >> 2) + 4 * hi; }
template <int s> __device__ __forceinline__ bf16x8 pack8(const f32x16& p) {
    u32x4 w; w.x = cvtpk(p[8 * s + 0], p[8 * s + 1]); w.y = cvtpk(p[8 * s + 2], p[8 * s + 3]); w.z = cvtpk(p[8 * s + 4], p[8 * s + 5]); w.w = cvtpk(p[8 * s + 6], p[8 * s + 7]);
    return __builtin_bit_cast(bf16x8, w);
}
__device__ __forceinline__ s16x4 vtr(LAS const unsigned char* p) {
    typedef short v4i16_t __attribute__((ext_vector_type(4)));
    return __builtin_bit_cast(s16x4, __builtin_amdgcn_ds_read_tr16_b64_v4i16((LAS v4i16_t*)p));
}
__device__ __forceinline__ bf16x8 vfrag(LAS const unsigned char* p, int pitch8) {
    const s16x4 lo = vtr(p), hi = vtr(p + pitch8);
    return (bf16x8){lo[0], lo[1], lo[2], lo[3], hi[0], hi[1], hi[2], hi[3]};
}
__device__ __forceinline__ int otid() { int t = threadIdx.x; asm volatile("" : "+v"(t)); return t; }
#define MFMA32(a, b, c) __builtin_amdgcn_mfma_f32_32x32x16_bf16((a), (b), (c), 0, 0, 0)

struct EpiQKV {
    static constexpr bool PERM = true, AFTER_DRAIN = false;
    bf16 *Q; const float* cosT; const float* sinT; float* kms; int even;
    __device__ __forceinline__ void operator()(const pg8::f32x4 (&acc)[2][2][4][2], const pg8::Unit& u, int wr, int wc, int fr, int fq) const {
        const int sec = u.pn >> 2, colt = (u.pn & 3) * 256;
        bf16* base = Q + (size_t)sec * (size_t)(16u << 20);
        if (even) {
            const int g4 = ((wc & 1) * 4 + fq) * 4;
            const float qs = sec == 0 ? 0.125f : 1.0f;
#pragma unroll
            for (int ai = 0; ai < 2; ++ai)
#pragma unroll
                for (int m = 0; m < 4; ++m) {
                    const int row = u.pm * 256 + ai * 128 + wr * 64 + m * 16 + fr;
                    f32x4 c = (f32x4){1.f, 1.f, 1.f, 1.f}, s = (f32x4){0.f, 0.f, 0.f, 0.f};
                    if (sec < 2) { c = *(const f32x4*)(cosT + (size_t)row * 32 + g4); s = *(const f32x4*)(sinT + (size_t)row * 32 + g4); }
#pragma unroll
                    for (int bj = 0; bj < 2; ++bj) {
                        const f32x4 v0 = acc[ai][bj][m][0], v1 = acc[ai][bj][m][1];
                        const f32x4 o1 = (v0 * c - v1 * s) * qs, o2 = (v1 * c + v0 * s) * qs;
                        bf16* p = base + (size_t)row * 1024 + colt + 128 * bj + (wc >> 1) * 64 + g4;
                        u32x2 w1, w2; w1.x = cvtpk(o1[0], o1[1]); w1.y = cvtpk(o1[2], o1[3]); w2.x = cvtpk(o2[0], o2[1]); w2.y = cvtpk(o2[2], o2[3]);
                        *(u32x2*)p = w1; *(u32x2*)(p + 32) = w2;
                    }
                }
            if (u.pn == 4) {
#pragma unroll
                for (int bj = 0; bj < 2; ++bj) {
                    f32x4 c1 = (f32x4){0.f, 0.f, 0.f, 0.f}, c2 = c1;
#pragma unroll
                    for (int ai = 0; ai < 2; ++ai)
#pragma unroll
                        for (int m = 0; m < 4; ++m) {
                            const int row = u.pm * 256 + ai * 128 + wr * 64 + m * 16 + fr;
                            const f32x4 c = *(const f32x4*)(cosT + (size_t)row * 32 + g4), s = *(const f32x4*)(sinT + (size_t)row * 32 + g4);
                            const f32x4 v0 = acc[ai][bj][m][0], v1 = acc[ai][bj][m][1];
                            c1 += v0 * c - v1 * s; c2 += v1 * c + v0 * s;
                        }
#pragma unroll
                    for (int j = 0; j < 4; ++j) {
                        float a = c1[j], b = c2[j];
                        a += __shfl_xor(a, 1); a += __shfl_xor(a, 2); a += __shfl_xor(a, 4); a += __shfl_xor(a, 8);
                        b += __shfl_xor(b, 1); b += __shfl_xor(b, 2); b += __shfl_xor(b, 4); b += __shfl_xor(b, 8);
                        if (fr == 0) { float* kp = kms + (size_t)u.pm * 256 + (2 * bj + (wc >> 1)) * 64 + g4 + j; atomicAdd(kp, a); atomicAdd(kp + 32, b); }
                    }
                }
            }
        } else {
            const float qs = sec == 0 ? 0.08838834764831845f : 1.0f;
#pragma unroll
            for (int ai = 0; ai < 2; ++ai)
#pragma unroll
                for (int m = 0; m < 4; ++m) {
                    const int row = u.pm * 256 + ai * 128 + wr * 64 + m * 16 + fr;
#pragma unroll
                    for (int bj = 0; bj < 2; ++bj) {
                        const f32x4 v0 = acc[ai][bj][m][0] * qs, v1 = acc[ai][bj][m][1] * qs;
                        u32x4 w; w.x = cvtpk(v0[0], v0[1]); w.y = cvtpk(v0[2], v0[3]); w.z = cvtpk(v1[0], v1[1]); w.w = cvtpk(v1[2], v1[3]);
                        *(u32x4*)(base + (size_t)row * 1024 + colt + 128 * bj + 32 * wc + 8 * fq) = w;
                    }
                }
        }
    }
};
struct EpiResid {
    static constexpr bool PERM = false, AFTER_DRAIN = false;
    const float* base; float* out;
    __device__ __forceinline__ void operator()(const pg8::f32x4 (&acc)[2][2][4][2], const pg8::Unit& u, int wr, int wc, int fr, int fq) const {
        const int col0 = u.pn * 256 + wc * 32 + 4 * fq;
#pragma unroll
        for (int ai = 0; ai < 2; ++ai)
#pragma unroll
            for (int m = 0; m < 4; ++m) {
                const size_t off = (size_t)(u.pm * 256 + ai * 128 + wr * 64 + m * 16 + fr) * 1024 + col0;
#pragma unroll
                for (int bj = 0; bj < 2; ++bj)
#pragma unroll
                    for (int n = 0; n < 2; ++n) {
                        const f32x4 bs = *(const f32x4*)(base + off + bj * 128 + n * 16);
                        *(f32x4*)(out + off + bj * 128 + n * 16) = bs * ALPHA + acc[ai][bj][m][n];
                    }
            }
    }
};

__device__ __forceinline__ int vmap(int mode, int n) {
    if (mode == 1) { const int d = n & 63, dd = d & 31; return (n & ~63) + ((dd >> 2) << 3) + ((d >> 5) << 2) + (dd & 3); }
    if (mode == 2) { const int isv = n >= F ? 1 : 0, ch = n - isv * F; return ((ch >> 2) << 3) + (isv << 2) + (ch & 3); }
    return n;
}
__device__ __forceinline__ void wconv_item(const float* W, int K, int N, bf16* WT, int mode, LAS float* scr, int item, int lane) {
    const int nblk = N / 32, kb = item / nblk, nb = item % nblk, k0 = 64 * kb, n0 = 32 * nb;
#pragma unroll 8
    for (int i = 0; i < 32; ++i) { const int kk = 2 * i + (lane >> 5); scr[kk * 33 + (lane & 31)] = W[(size_t)(k0 + kk) * N + n0 + (lane & 31)]; }
    asm volatile("s_waitcnt lgkmcnt(0)" ::: "memory");
    const int c = lane & 7;
#pragma unroll
    for (int j = 0; j < 4; ++j) { const int n = (lane >> 3) + 8 * j; const LAS float* s = scr + (8 * c) * 33 + n;
        u32x4 o; o.x = cvtpk(s[0 * 33], s[1 * 33]); o.y = cvtpk(s[2 * 33], s[3 * 33]); o.z = cvtpk(s[4 * 33], s[5 * 33]); o.w = cvtpk(s[6 * 33], s[7 * 33]);
        *(u32x4*)(WT + (size_t)vmap(mode, n0 + n) * K + k0 + 8 * c) = o; }
    asm volatile("s_waitcnt lgkmcnt(0)" ::: "memory");
}
constexpr int WI_QKV = 16 * 96, WI_O = 16 * 32, WI_UP = 16 * 176, WI_DN = 44 * 32, WI_ALL = WI_QKV + WI_O + WI_UP + WI_DN;
struct Params { const float* in[13]; float* out; unsigned char* ws; };
__device__ __forceinline__ void wconv_layer_item(const Params& P, int L, int it, LAS float* scr, int lane) {
    unsigned char* wb = P.ws + ((L & 1) ? WS_W1 : WS_W0);
    const int h = L >> 1, ev = !(L & 1);
    if (it < WI_QKV) { wconv_item((ev ? P.in[1] : P.in[3]) + (size_t)h * D * 3072, D, 3072, (bf16*)(wb + WO_QKV), ev ? 1 : 0, scr, it, lane); return; } it -= WI_QKV;
    if (it < WI_O) { wconv_item((ev ? P.in[2] : P.in[4]) + (size_t)h * D * D, D, D, (bf16*)(wb + WO_O), 0, scr, it, lane); return; } it -= WI_O;
    if (it < WI_UP) { wconv_item(P.in[7] + (size_t)L * D * F2, D, F2, (bf16*)(wb + WO_UP), 2, scr, it, lane); return; } it -= WI_UP;
    wconv_item(P.in[10] + (size_t)L * F * D, F, D, (bf16*)(wb + WO_DN), 0, scr, it, lane);
}

__device__ __forceinline__ float wave_sum(float v) {
#pragma unroll
    for (int o = 1; o < 64; o <<= 1) v += __shfl_xor(v, o);
    return v;
}
__device__ __forceinline__ void ln_row(float* yrow, bf16* hrow, const float* g, const float* b, int lane) {
    f32x4* yr = (f32x4*)yrow + lane;
    f32x4 v[4]; float s = 0.f;
#pragma unroll
    for (int j = 0; j < 4; ++j) { v[j] = yr[64 * j]; s += (v[j].x + v[j].y) + (v[j].z + v[j].w); }
    const float mean = wave_sum(s) * (1.f / D); float s2 = 0.f;
#pragma unroll
    for (int j = 0; j < 4; ++j) { v[j] = v[j] - mean; s2 += (v[j].x * v[j].x + v[j].y * v[j].y) + (v[j].z * v[j].z + v[j].w * v[j].w); }
    const float rstd = 1.f / sqrtf(wave_sum(s2) * (1.f / D) + LN_EPS);
    u32x2* o8 = (u32x2*)hrow + lane;
#pragma unroll
    for (int j = 0; j < 4; ++j) {
        const f32x4 gg = *((const f32x4*)g + lane + 64 * j), bb = *((const f32x4*)b + lane + 64 * j);
        const f32x4 o = v[j] * rstd * gg + bb;
        yr[64 * j] = o;
        u32x2 w; w.x = cvtpk(o.x, o.y); w.y = cvtpk(o.z, o.w); o8[64 * j] = w;
    }
}

__device__ __forceinline__ void unpack8(const u32x4 w, f32x4& g, f32x4& v) {
    g = (f32x4){__uint_as_float(w.x << 16), __uint_as_float(w.x & 0xffff0000u), __uint_as_float(w.y << 16), __uint_as_float(w.y & 0xffff0000u)};
    v = (f32x4){__uint_as_float(w.z << 16), __uint_as_float(w.z & 0xffff0000u), __uint_as_float(w.w << 16), __uint_as_float(w.w & 0xffff0000u)};
}
__device__ __forceinline__ void conv_item(const bf16* U, bf16* A, const float* cw, const float* cb, int item, int lane) {
    const int chunk = item / 11, cbk = item % 11, cg_ = cbk * 64 + lane, v0 = cg_ * 8, ch0 = cg_ * 4, t0 = chunk * 32;
    f32x4 wg[3], wv[3];
#pragma unroll
    for (int j = 0; j < 3; ++j) { wg[j] = *(const f32x4*)(cw + (size_t)j * F2 + ch0); wv[j] = *(const f32x4*)(cw + (size_t)j * F2 + F + ch0); }
    const f32x4 bg = *(const f32x4*)(cb + ch0), bv = *(const f32x4*)(cb + F + ch0);
    f32x4 g2 = (f32x4){0.f, 0.f, 0.f, 0.f}, v2 = g2, g1 = g2, v1 = g2;
    if (t0 >= 2) { unpack8(*(const u32x4*)(U + (size_t)(t0 - 2) * F2 + v0), g2, v2); unpack8(*(const u32x4*)(U + (size_t)(t0 - 1) * F2 + v0), g1, v1); }
#pragma unroll 4
    for (int t = t0; t < t0 + 32; ++t) {
        f32x4 g0, vv0; unpack8(*(const u32x4*)(U + (size_t)t * F2 + v0), g0, vv0);
        const f32x4 cgv = bg + wg[0] * g2 + wg[1] * g1 + wg[2] * g0;
        const f32x4 cvv = bv + wv[0] * v2 + wv[1] * v1 + wv[2] * vv0;
        f32x4 o;
#pragma unroll
        for (int j = 0; j < 4; ++j) { const float x = cgv[j]; o[j] = x / (1.0f + __builtin_amdgcn_exp2f(-x * L2E)) * cvv[j]; }
        u32x2 w; w.x = cvtpk(o[0], o[1]); w.y = cvtpk(o[2], o[3]);
        *(u32x2*)(A + (size_t)t * F + ch0) = w;
        g2 = g1; v2 = v1; g1 = g0; v1 = vv0;
    }
}

__device__ __forceinline__ void softmax_block(const f32x16& z, unsigned vmask, float& m, float& l, f32x16 (&o)[2], LAS float* wsf, LAS const unsigned char* vp, int VP, int r, int hh) {
    float zm = -1e30f;
#pragma unroll
    for (int i = 0; i < 16; ++i) zm = fmaxf(zm, ((vmask >> i) & 1u) ? z[i] : -1e30f);
    zm = fmaxf(zm, __shfl_xor(zm, 32));
    const float mn = fmaxf(m, zm);
    if (__any(mn > m)) {
        const float al = __builtin_amdgcn_exp2f((m - mn) * L2E);
        l *= al;
        if (hh == 0) wsf[r] = al;
        asm volatile("s_waitcnt lgkmcnt(0)" ::: "memory");
#pragma unroll
        for (int i = 0; i < 16; ++i) { const float f = wsf[crow(i, hh)]; o[0][i] *= f; o[1][i] *= f; }
        asm volatile("s_waitcnt lgkmcnt(0)" ::: "memory");
        m = mn;
    }
    f32x16 p; float ls = 0.f;
#pragma unroll
    for (int i = 0; i < 16; ++i) { const float pi = ((vmask >> i) & 1u) ? __builtin_amdgcn_exp2f((z[i] - m) * L2E) : 0.f; p[i] = pi; ls += pi; }
    l += ls;
    const bf16x8 a0 = pack8<0>(p), a1 = pack8<1>(p);
#pragma unroll
    for (int db = 0; db < 2; ++db) {
        o[db] = MFMA32(a0, vfrag(vp + db * 64, 8 * VP), o[db]);
        o[db] = MFMA32(a1, vfrag(vp + 16 * VP + db * 64, 8 * VP), o[db]);
    }
}
#define FINISH_STORE(ROWEXPR) do { \
    const float lt = l + __shfl_xor(l, 32); \
    if (hh == 0) wsf[r] = 1.0f / lt; \
    asm volatile("s_waitcnt lgkmcnt(0)" ::: "memory"); \
    _Pragma("unroll") for (int i = 0; i < 16; ++i) { const float f = wsf[crow(i, hh)]; const int qi = crow(i, hh); const size_t t_ = (size_t)(ROWEXPR); \
        _Pragma("unroll") for (int db = 0; db < 2; ++db) Ob[t_ * 1024 + hcol + db * 32 + r] = (bf16)(cvtpk(o[db][i] * f, 0.f) & 0xffffu); } \
    asm volatile("s_waitcnt lgkmcnt(0)" ::: "memory"); } while (0)

struct GBlk {
    int row0, nst, dstep;
    __device__ __forceinline__ int nsteps() const { return nst; }
    __device__ __forceinline__ int row(int st, int kk) const { return row0 + 32 * st + kk; }
    __device__ __forceinline__ unsigned mask(int st, int r, int hh) const {
        if (st != dstep) return 0xffffu;
        unsigned vm = 0u;
#pragma unroll
        for (int i = 0; i < 16; ++i) vm |= (crow(i, hh) <= r) ? (1u << i) : 0u;
        return vm;
    }
};
struct GDil {
    int c, tb;
    __device__ __forceinline__ int nsteps() const { return 33; }
    __device__ __forceinline__ void bp(int st, int& dil, int& cls, int& ub, int& qstep, int& blk) const {
        const int br = st < 20 ? 0 : (st < 28 ? 1 : 2); blk = st - (br == 0 ? 0 : (br == 1 ? 20 : 28));
        dil = br == 0 ? 1 : (br == 1 ? 4 : 16); qstep = br == 0 ? 16 : (br == 1 ? 4 : 1);
        cls = br == 0 ? 0 : (br == 1 ? (c & 3) : c);
        const int I0 = br == 0 ? (512 * tb + c) : (br == 1 ? (128 * tb + (c >> 2)) : 32 * tb);
        ub = I0 - 128 + 32 * blk;
    }
    __device__ __forceinline__ int row(int st, int kk) const {
        int dil, cls, ub, qstep, blk; bp(st, dil, cls, ub, qstep, blk);
        int pos = cls + dil * (ub + kk); return pos < 0 ? 0 : (pos > S - 1 ? S - 1 : pos);
    }
    __device__ __forceinline__ unsigned mask(int st, int r, int hh) const {
        int dil, cls, ub, qstep, blk; bp(st, dil, cls, ub, qstep, blk);
        unsigned vm = 0u;
#pragma unroll
        for (int i = 0; i < 16; ++i) { const int kk = crow(i, hh), dl = 128 + qstep * r - 32 * blk - kk; vm |= (dl >= 0 && dl <= 128 && (ub + kk) >= 0) ? (1u << i) : 0u; }
        return vm;
    }
};
template <class G>
__device__ __forceinline__ void attn_group(const G& g, const bf16x8 (&qf)[4], const bf16* Kb, const bf16* Vb, int hcol, LAS unsigned char* vst, LAS float* wsf,
                                           float& m, float& l, f32x16 (&o)[2], int lane, int r, int hh) {
    constexpr int VP = 192;
    const int ns = g.nsteps();
    bf16x8 kf[4]; u32x4 vr[4];
    { const bf16* kp = Kb + (size_t)g.row(0, r) * 1024 + hcol + hh * 8;
#pragma unroll
      for (int ks = 0; ks < 4; ++ks) kf[ks] = *(const bf16x8*)(kp + ks * 16);
#pragma unroll
      for (int i = 0; i < 4; ++i) vr[i] = *(const u32x4*)(Vb + (size_t)g.row(0, (lane >> 3) + 8 * i) * 1024 + hcol + (lane & 7) * 8); }
    LAS const unsigned char* vp = vst + (4 * hh + ((lane & 15) >> 2)) * VP + (((lane >> 4) & 1) * 16 + (lane & 3) * 4) * 2;
    for (int st = 0; st < ns; ++st) {
        bf16x8 kn[4]; u32x4 vn[4];
        const int sn = st + 1 < ns ? st + 1 : st;
        { const bf16* kp = Kb + (size_t)g.row(sn, r) * 1024 + hcol + hh * 8;
#pragma unroll
          for (int ks = 0; ks < 4; ++ks) kn[ks] = *(const bf16x8*)(kp + ks * 16);
#pragma unroll
          for (int i = 0; i < 4; ++i) vn[i] = *(const u32x4*)(Vb + (size_t)g.row(sn, (lane >> 3) + 8 * i) * 1024 + hcol + (lane & 7) * 8); }
        f32x16 z = (f32x16){0.f, 0.f, 0.f, 0.f, 0.f, 0.f, 0.f, 0.f, 0.f, 0.f, 0.f, 0.f, 0.f, 0.f, 0.f, 0.f};
#pragma unroll
        for (int ks = 0; ks < 4; ++ks) z = MFMA32(kf[ks], qf[ks], z);
        asm volatile("s_waitcnt lgkmcnt(0)" ::: "memory");
#pragma unroll
        for (int i = 0; i < 4; ++i) *(LAS u32x4*)(vst + ((lane >> 3) + 8 * i) * VP + (lane & 7) * 16) = vr[i];
        asm volatile("s_waitcnt lgkmcnt(0)" ::: "memory");
        const unsigned vm = g.mask(st, r, hh);
        softmax_block(z, vm, m, l, o, wsf, vp, VP, r, hh);
#pragma unroll
        for (int ks = 0; ks < 4; ++ks) kf[ks] = kn[ks];
#pragma unroll
        for (int i = 0; i < 4; ++i) vr[i] = vn[i];
    }
}

constexpr int PB_STRIDE = 72;
__device__ __forceinline__ float* pb_ptr(float* PB, int qrow, int head, int slot) { return PB + (((size_t)qrow * 4 + head) * 4 + slot) * PB_STRIDE; }
__device__ __forceinline__ void moba_unit(LAS unsigned char* lds, const bf16* Qb, const bf16* Kb, const bf16* Vb, bf16* Ob, float* PB, const float* kms, int head, int qb) {
    const int tid = otid(), lane = tid & 63, wid = __builtin_amdgcn_readfirstlane(tid >> 6), r = lane & 31, hh = lane >> 5;
    constexpr int VP = 192;
    const int hcol = head * 64, q0 = qb * 256, qw0 = q0 + wid * 32;
    LAS float* wsf = (LAS float*)(lds + ATT_SCR_OFF + wid * 128);
    LAS unsigned char* vst = lds + wid * (32 * VP);
    LAS unsigned* selL = (LAS unsigned*)(lds + 49152);
    LAS unsigned short* lst = (LAS unsigned short*)(lds + 52224 + wid * 512);
    LAS unsigned* tab = (LAS unsigned*)(lds + 57344 + wid * 256);
    bf16x8 qf[4];
#pragma unroll
    for (int ks = 0; ks < 4; ++ks) qf[ks] = *(const bf16x8*)(Qb + (size_t)(qw0 + r) * 1024 + hcol + ks * 16 + hh * 8);
    unsigned mlo = 0u, mhi = 0u;
    if (qb > 0) {
        f32x16 gt[2];
#pragma unroll
        for (int nb = 0; nb < 2; ++nb) {
            gt[nb] = (f32x16){0.f, 0.f, 0.f, 0.f, 0.f, 0.f, 0.f, 0.f, 0.f, 0.f, 0.f, 0.f, 0.f, 0.f, 0.f, 0.f};
#pragma unroll
            for (int ks = 0; ks < 4; ++ks) {
                const float* kp = kms + (size_t)(nb * 32 + r) * 256 + hcol + ks * 16 + hh * 8;
                const f32x4 a = *(const f32x4*)kp * (1.0f / 256.0f), b = *(const f32x4*)(kp + 4) * (1.0f / 256.0f);
                u32x4 w; w.x = cvtpk(a[0], a[1]); w.y = cvtpk(a[2], a[3]); w.z = cvtpk(b[0], b[1]); w.w = cvtpk(b[2], b[3]);
                gt[nb] = MFMA32(__builtin_bit_cast(bf16x8, w), qf[ks], gt[nb]);
            }
        }
        float ta = -INFINITY, tb = -INFINITY, tc = -INFINITY;
#pragma unroll
        for (int nb = 0; nb < 2; ++nb)
#pragma unroll
            for (int i = 0; i < 16; ++i) {
                const int n = nb * 32 + crow(i, hh);
                const float v = n < qb ? gt[nb][i] : -INFINITY; gt[nb][i] = v;
                tc = fmaxf(tc, fminf(tb, v)); tb = fmaxf(tb, fminf(ta, v)); ta = fmaxf(ta, v);
            }
        const float oa = __shfl_xor(ta, 32), ob = __shfl_xor(tb, 32), oc = __shfl_xor(tc, 32);
        { float v = oa; tc = fmaxf(tc, fminf(tb, v)); tb = fmaxf(tb, fminf(ta, v)); ta = fmaxf(ta, v);
          v = ob; tc = fmaxf(tc, fminf(tb, v)); tb = fmaxf(tb, fminf(ta, v)); ta = fmaxf(ta, v);
          v = oc; tc = fmaxf(tc, fminf(tb, v)); tb = fmaxf(tb, fminf(ta, v)); ta = fmaxf(ta, v); }
#pragma unroll
        for (int i = 0; i < 16; ++i) {
            const int n0 = crow(i, hh);
            if (n0 < qb && gt[0][i] >= tc) mlo |= 1u << n0;
            if (n0 + 32 < qb && gt[1][i] >= tc) mhi |= 1u << n0;
        }
        mlo |= __shfl_xor(mlo, 32); mhi |= __shfl_xor(mhi, 32);
    }
    if (hh == 0) { selL[(wid * 32 + r) * 2] = mlo; selL[(wid * 32 + r) * 2 + 1] = mhi; }
    {
        float m = -1e30f, l = 0.f; f32x16 o[2];
        o[0] = (f32x16){0.f, 0.f, 0.f, 0.f, 0.f, 0.f, 0.f, 0.f, 0.f, 0.f, 0.f, 0.f, 0.f, 0.f, 0.f, 0.f}; o[1] = o[0];
        GBlk g{q0, wid + 1, wid};
        attn_group(g, qf, Kb, Vb, hcol, vst, wsf, m, l, o, lane, r, hh);
#pragma unroll
        for (int i = 0; i < 16; ++i) { float* pb = pb_ptr(PB, qw0 + crow(i, hh), head, 3); pb[r] = o[0][i]; pb[32 + r] = o[1][i]; }
        const float lt = l + __shfl_xor(l, 32);
        if (hh == 0) { float* pb = pb_ptr(PB, qw0 + r, head, 3); pb[64] = m; pb[65] = lt; }
    }
    __syncthreads();
    asm volatile("" : "+s"(PB));
    for (int n = wid; n < qb; n += 8) {
        int cnt = 0;
#pragma unroll
        for (int c4 = 0; c4 < 4; ++c4) {
            const int q = 64 * c4 + lane;
            const unsigned w = n < 32 ? (selL[q * 2] >> n) : (selL[q * 2 + 1] >> (n - 32));
            const int bit = (int)(w & 1u);
            const unsigned long long bm = __ballot(bit);
            const int pos = cnt + __popcll(bm & ((1ull << lane) - 1ull));
            if (bit) lst[pos] = (unsigned short)q;
            cnt += __popcll(bm);
        }
        asm volatile("s_waitcnt lgkmcnt(0)" ::: "memory");
        for (int g0 = 0; g0 < cnt; g0 += 32) {
            const int li = g0 + r; const bool valid = li < cnt; const int qi = lst[valid ? li : g0];
            const unsigned slo = selL[qi * 2], shi = selL[qi * 2 + 1];
            const int slot = n < 32 ? __popc(slo & ((1u << n) - 1u)) : (__popc(slo) + __popc(shi & ((1u << (n - 32)) - 1u)));
            const bool ok = valid && slot < 3;
            if (hh == 0) tab[r] = (unsigned)qi | ((unsigned)slot << 16) | (ok ? (1u << 24) : 0u);
            bf16x8 qg[4];
#pragma unroll
            for (int ks = 0; ks < 4; ++ks) qg[ks] = *(const bf16x8*)(Qb + (size_t)(q0 + qi) * 1024 + hcol + ks * 16 + hh * 8);
            float m2 = -1e30f, l2 = 0.f; f32x16 o2[2];
            o2[0] = (f32x16){0.f, 0.f, 0.f, 0.f, 0.f, 0.f, 0.f, 0.f, 0.f, 0.f, 0.f, 0.f, 0.f, 0.f, 0.f, 0.f}; o2[1] = o2[0];
            GBlk g{n * 256, 8, -1};
            attn_group(g, qg, Kb, Vb, hcol, vst, wsf, m2, l2, o2, lane, r, hh);
            asm volatile("s_waitcnt lgkmcnt(0)" ::: "memory");
#pragma unroll
            for (int i = 0; i < 16; ++i) { const unsigned t = tab[crow(i, hh)];
                if (t >> 24) { float* pb = pb_ptr(PB, q0 + (int)(t & 0xffffu), head, (int)((t >> 16) & 0xffu)); pb[r] = o2[0][i]; pb[32 + r] = o2[1][i]; } }
            const float lt = l2 + __shfl_xor(l2, 32);
            if (hh == 0 && ok) { float* pb = pb_ptr(PB, q0 + qi, head, slot); pb[64] = m2; pb[65] = lt; }
            asm volatile("s_waitcnt lgkmcnt(0)" ::: "memory");
        }
    }
    __threadfence();
    __syncthreads();
    {
        asm volatile("" : "+s"(PB)); int qw0c = qw0; asm volatile("" : "+s"(qw0c));
        const int nsel = qb < 3 ? qb : 3;
        float ms[16], L[16]; f32x16 oc[2];
        oc[0] = (f32x16){0.f, 0.f, 0.f, 0.f, 0.f, 0.f, 0.f, 0.f, 0.f, 0.f, 0.f, 0.f, 0.f, 0.f, 0.f, 0.f}; oc[1] = oc[0];
#pragma unroll
        for (int i = 0; i < 16; ++i) { const int qrow = qw0c + crow(i, hh); float mm = pb_ptr(PB, qrow, head, 3)[64];
            for (int s = 0; s < nsel; ++s) mm = fmaxf(mm, pb_ptr(PB, qrow, head, s)[64]);
            ms[i] = mm; L[i] = 0.f; }
        for (int s = -1; s < nsel; ++s) {
            const int slot = s < 0 ? 3 : s;
#pragma unroll
            for (int i = 0; i < 16; ++i) { const float* pb = pb_ptr(PB, qw0c + crow(i, hh), head, slot);
                const float w = __builtin_amdgcn_exp2f((pb[64] - ms[i]) * L2E);
                L[i] += w * pb[65]; oc[0][i] += w * pb[r]; oc[1][i] += w * pb[32 + r]; }
        }
#pragma unroll
        for (int i = 0; i < 16; ++i) { const float f = 1.0f / L[i]; const size_t t_ = (size_t)(qw0c + crow(i, hh));
            Ob[t_ * 1024 + hcol + r] = (bf16)(cvtpk(oc[0][i] * f, 0.f) & 0xffffu); Ob[t_ * 1024 + hcol + 32 + r] = (bf16)(cvtpk(oc[1][i] * f, 0.f) & 0xffffu); }
    }
    __syncthreads();
}

__device__ __forceinline__ void dilated_unit(LAS unsigned char* lds, const bf16* Qb, const bf16* Kb, const bf16* Vb, bf16* Ob, int head, int tb) {
    const int tid = otid(), lane = tid & 63, wid = __builtin_amdgcn_readfirstlane(tid >> 6), r = lane & 31, hh = lane >> 5;
    constexpr int VP = 192;
    const int hcol = head * 64, T0 = tb * 512;
    LAS float* wsf = (LAS float*)(lds + ATT_SCR_OFF + wid * 128);
    LAS unsigned char* vst = lds + wid * (32 * VP);
    for (int e = 0; e < 2; ++e) {
        const int c = 2 * wid + e;
        bf16x8 qf[4];
#pragma unroll
        for (int ks = 0; ks < 4; ++ks) qf[ks] = *(const bf16x8*)(Qb + (size_t)(T0 + c + 16 * r) * 1024 + hcol + ks * 16 + hh * 8);
        float m = -1e30f, l = 0.f; f32x16 o[2];
        o[0] = (f32x16){0.f, 0.f, 0.f, 0.f, 0.f, 0.f, 0.f, 0.f, 0.f, 0.f, 0.f, 0.f, 0.f, 0.f, 0.f, 0.f}; o[1] = o[0];
        GDil g{c, tb};
        attn_group(g, qf, Kb, Vb, hcol, vst, wsf, m, l, o, lane, r, hh);
        FINISH_STORE(T0 + c + 16 * qi);
    }
}

__device__ __forceinline__ void sb_unit(LAS unsigned char* lds, const bf16* Qb, const bf16* Kb, const bf16* Vb, bf16* Ob, int head, int qb) {
    const int tid = otid(), lane = tid & 63, wid = __builtin_amdgcn_readfirstlane(tid >> 6), r = lane & 31, hh = lane >> 5;
    constexpr int KP = 272, VP = 320, KBY = 64 * KP, VBY = 64 * VP, BUF = KBY + VBY;
    const int qw0 = qb * 256 + wid * 32, hcol = head * 128;
    bf16x8 qf[8];
#pragma unroll
    for (int ks = 0; ks < 8; ++ks) qf[ks] = *(const bf16x8*)(Qb + (size_t)(qw0 + r) * 1024 + hcol + ks * 16 + hh * 8);
    bf16x8 uf[2];
#pragma unroll
    for (int s = 0; s < 2; ++s)
#pragma unroll
        for (int j = 0; j < 8; ++j) { const int k = 16 * s + 8 * (j >> 2) + 4 * hh + (j & 3); uf[s][j] = (k >= r) ? (short)0x3F80 : (short)0; }
    f32x16 o[4];
#pragma unroll
    for (int db = 0; db < 4; ++db) o[db] = (f32x16){0.f, 0.f, 0.f, 0.f, 0.f, 0.f, 0.f, 0.f, 0.f, 0.f, 0.f, 0.f, 0.f, 0.f, 0.f, 0.f};
    float Rc = 0.f;
    const int NT = 4 * qb + 4;
    const int srow = tid >> 4, sc16 = tid & 15;
    u32x4 kreg[2], vreg[2];
#pragma unroll
    for (int i = 0; i < 2; ++i) { const size_t g = (size_t)((NT - 1) * 64 + srow + 32 * i) * 1024 + hcol + sc16 * 8; kreg[i] = *(const u32x4*)(Kb + g); vreg[i] = *(const u32x4*)(Vb + g); }
#pragma unroll
    for (int i = 0; i < 2; ++i) { *(LAS u32x4*)(lds + (srow + 32 * i) * KP + sc16 * 16) = kreg[i]; *(LAS u32x4*)(lds + KBY + (srow + 32 * i) * VP + sc16 * 16) = vreg[i]; }
    __syncthreads();
    int buf = 0;
    for (int kt = NT - 1; kt >= 0; --kt) {
        if (kt > 0) {
#pragma unroll
            for (int i = 0; i < 2; ++i) { const size_t g = (size_t)((kt - 1) * 64 + srow + 32 * i) * 1024 + hcol + sc16 * 8; kreg[i] = *(const u32x4*)(Kb + g); vreg[i] = *(const u32x4*)(Vb + g); }
        }
        const bool wdone = __all(Rc >= 104.0f);
        if (!wdone) {
            LAS const unsigned char* kb_ = lds + buf * BUF; LAS const unsigned char* vb_ = kb_ + KBY;
#pragma unroll
            for (int kbi = 0; kbi < 2; ++kbi) {
                const int kb = 1 - kbi, kb0 = kt * 64 + kb * 32;
                if (kb0 >= qw0 + 31) continue;
                const bool need_mask = (kb0 + 31 >= qw0);
                f32x16 z = (f32x16){0.f, 0.f, 0.f, 0.f, 0.f, 0.f, 0.f, 0.f, 0.f, 0.f, 0.f, 0.f, 0.f, 0.f, 0.f, 0.f};
                LAS const unsigned char* kp = kb_ + (kb * 32 + r) * KP + hh * 16;
#pragma unroll
                for (int ks = 0; ks < 8; ++ks) z = MFMA32(*(LAS const bf16x8*)(kp + ks * 32), qf[ks], z);
                unsigned vm = 0xffffu;
                if (need_mask) { vm = 0u;
#pragma unroll
                    for (int i = 0; i < 16; ++i) vm |= ((kb0 + crow(i, hh)) < (qw0 + r)) ? (1u << i) : 0u; }
                f32x16 sp;
#pragma unroll
                for (int i = 0; i < 16; ++i) { const float zi = z[i]; const float e = __builtin_amdgcn_exp2f(-fabsf(zi) * L2E);
                    const float s_ = fmaxf(zi, 0.f) + LN2 * __builtin_amdgcn_logf(1.0f + e); sp[i] = ((vm >> i) & 1u) ? s_ : 0.f; }
                f32x16 rin = (f32x16){0.f, 0.f, 0.f, 0.f, 0.f, 0.f, 0.f, 0.f, 0.f, 0.f, 0.f, 0.f, 0.f, 0.f, 0.f, 0.f};
                rin = MFMA32(uf[0], pack8<0>(sp), rin);
                rin = MFMA32(uf[1], pack8<1>(sp), rin);
                f32x16 a;
#pragma unroll
                for (int i = 0; i < 16; ++i) { const float ai = __builtin_amdgcn_exp2f((z[i] - rin[i] - Rc) * L2E); a[i] = ((vm >> i) & 1u) ? ai : 0.f; }
                Rc += __shfl(rin[0], r);
                const bf16x8 a0 = pack8<0>(a), a1 = pack8<1>(a);
                LAS const unsigned char* vp = vb_ + (kb * 32 + 4 * hh + ((lane & 15) >> 2)) * VP + (((lane >> 4) & 1) * 16 + (lane & 3) * 4) * 2;
#pragma unroll
                for (int db = 0; db < 4; ++db) {
                    o[db] = MFMA32(a0, vfrag(vp + db * 64, 8 * VP), o[db]);
                    o[db] = MFMA32(a1, vfrag(vp + 16 * VP + db * 64, 8 * VP), o[db]);
                }
            }
        }
        if (kt > 0) { LAS unsigned char* d = lds + (buf ^ 1) * BUF;
#pragma unroll
            for (int i = 0; i < 2; ++i) { *(LAS u32x4*)(d + (srow + 32 * i) * KP + sc16 * 16) = kreg[i]; *(LAS u32x4*)(d + KBY + (srow + 32 * i) * VP + sc16 * 16) = vreg[i]; } }
        LAS unsigned* flg = (LAS unsigned*)(lds + ATT_SCR_OFF + 1024) + (kt & 1) * 8;
        if (lane == 0) flg[wid] = wdone ? 1u : 0u;
        __syncthreads();
        buf ^= 1;
        const u32x4 f0 = *(LAS const u32x4*)flg, f1 = *(LAS const u32x4*)(flg + 4);
        if ((f0.x & f0.y & f0.z & f0.w & f1.x & f1.y & f1.z & f1.w) != 0u) break;
    }
#pragma unroll
    for (int db = 0; db < 4; ++db)
#pragma unroll
        for (int i = 0; i < 16; ++i) Ob[(size_t)(qw0 + crow(i, hh)) * 1024 + hcol + db * 32 + r] = (bf16)(cvtpk(o[db][i], 0.f) & 0xffffu);
    __syncthreads();
}


#define XB_TMO      128
#define XB_XCNT(j)  (256  + 64 * (j))
#define XB_XSUB(j)  (1280 + 64 * (j))
#define XB_XGEN(j)  (2304 + 64 * (j))
#define XB_TOP      3328
#define XB_TOPGEN   3392
#define XCD_BAR_WORDS 3456
#define XB_SPIN_CAP (1u << 18)

__device__ __forceinline__ unsigned xb_ld(unsigned* p)              { return __hip_atomic_load(p, __ATOMIC_RELAXED, __HIP_MEMORY_SCOPE_AGENT); }
__device__ __forceinline__ unsigned xb_add(unsigned* p, unsigned v) { return __hip_atomic_fetch_add(p, v, __ATOMIC_RELAXED, __HIP_MEMORY_SCOPE_AGENT); }
__device__ __forceinline__ unsigned xb_xcc_id() { return (unsigned)__builtin_amdgcn_s_getreg((3 << 11) | 20) & 0xFu; }
#define XB_SPIN(cond, bar) do { unsigned _sp = 0; while (cond) { __builtin_amdgcn_s_sleep(1); \
    if ((++_sp & 255u) == 0u) { if (xb_ld(&(bar)[XB_TMO])) break; if (_sp > XB_SPIN_CAP) { atomicAdd(&(bar)[XB_TMO], 1u); break; } } } } while (0)

struct XcdBarrier {
    unsigned* bar; unsigned x;
    volatile LAS unsigned* st;
};

__device__ __forceinline__ XcdBarrier xcd_barrier_post(unsigned* bar, volatile LAS unsigned* st) {
    XcdBarrier b; b.bar = bar; b.x = xb_xcc_id(); b.st = st;
    if (threadIdx.x == 0) (void)xb_add(&bar[XB_XCNT(b.x)], 1u);
    return b;
}
__device__ __forceinline__ void xcd_barrier_complete(unsigned* bar, unsigned x, unsigned& nloc, unsigned& nx) {
    const unsigned G = gridDim.x * gridDim.y * gridDim.z;
    unsigned sum, cnt, mine, sp = 0u;
    for (;;) {
        sum = 0u; cnt = 0u; mine = 0u;
#pragma unroll
        for (unsigned j = 0; j < 16; ++j) { const unsigned c = xb_ld(&bar[XB_XCNT(j)]); sum += c; cnt += (c > 0u) ? 1u : 0u; mine = (j == x) ? c : mine; }
        if (sum == G) break;
        __builtin_amdgcn_s_sleep(1);
        if ((++sp & 255u) == 0u) { if (xb_ld(&bar[XB_TMO])) break; if (sp > XB_SPIN_CAP) { atomicAdd(&bar[XB_TMO], 1u); break; } }
    }
    nloc = mine > 0u ? mine : 1u; nx = cnt > 0u ? cnt : 1u;
}

__device__ __forceinline__ void xcd_barrier(const XcdBarrier& b) {
    asm volatile("s_waitcnt vmcnt(0)" ::: "memory");
    __syncthreads();
    if (threadIdx.x == 0) {
        unsigned* bar = b.bar;
        __builtin_amdgcn_s_waitcnt(0);
        unsigned nloc = b.st[0], nx = b.st[1];
        if (nloc == 0u) { xcd_barrier_complete(bar, b.x, nloc, nx); b.st[0] = nloc; b.st[1] = nx; }
        const unsigned old = xb_add(&bar[XB_XSUB(b.x)], 1u);
        const unsigned gen = old / nloc;
        if (old + 1u == (gen + 1u) * nloc) {
            __builtin_amdgcn_fence(__ATOMIC_RELEASE, "agent");
            asm volatile("s_waitcnt vmcnt(0)" ::: "memory");
            const unsigned og = xb_add(&bar[XB_TOP], 1u);
            const unsigned tg = og / nx;
            if (og + 1u == (tg + 1u) * nx) xb_add(&bar[XB_TOPGEN], 1u);
            else XB_SPIN(xb_ld(&bar[XB_TOPGEN]) == tg, bar);
            __builtin_amdgcn_fence(__ATOMIC_ACQUIRE, "agent");
            xb_add(&bar[XB_XGEN(b.x)], 1u);
            asm volatile("s_waitcnt vmcnt(0)" ::: "memory");
        } else {
            XB_SPIN(xb_ld(&bar[XB_XGEN(b.x)]) == gen, bar);
            __builtin_amdgcn_fence(__ATOMIC_ACQUIRE, "agent");
            asm volatile("s_waitcnt vmcnt(0)" ::: "memory");
        }
    }
    __syncthreads();
}


#ifdef SKIP_MOBA
#define MOBA2(head, p) do {} while (0)
#else
#define MOBA2(head, qb) moba_unit(lds, Qb, Kb, Vb, Ob, (float*)A, kl, head, qb)
#endif
#ifdef SKIP_DIL
#define DIL1(h, t) do {} while (0)
#else
#define DIL1(h, t) dilated_unit(lds, Qb, Kb, Vb, Ob, h, t)
#endif
#ifdef SKIP_SB
#define SB1(h, q) do {} while (0)
#else
#define SB1(h, q) sb_unit(lds, Qb, Kb, Vb, Ob, h, q)
#endif
#ifdef SKIP_GEMM1
#define GEMMCALL1 if (0)
#else
#define GEMMCALL1
#endif
#ifdef SKIP_GEMM2
#define GEMMCALL2 if (0)
#else
#define GEMMCALL2
#endif
#ifdef SKIP_GEMM3
#define GEMMCALL3 if (0)
#else
#define GEMMCALL3
#endif
#ifdef SKIP_GEMM4
#define GEMMCALL4 if (0)
#else
#define GEMMCALL4
#endif
__global__ void __launch_bounds__(512, 2) mega_fwd(Params P) {
    extern __shared__ __attribute__((aligned(16))) unsigned char lds_raw[];
    cg::grid_group grid = cg::this_grid();
    LAS unsigned char* lds = (LAS unsigned char*)lds_raw;
    const int G = gridDim.x, bid = blockIdx.x, NGW = G * 8, NTH = G * 512;
    volatile LAS unsigned* bst = (volatile LAS unsigned*)(lds + ATT_SCR_OFF + 2048);
    if (threadIdx.x < 2) bst[threadIdx.x] = 0u;
    __syncthreads();
    XcdBarrier bar = xcd_barrier_post((unsigned*)(P.ws + WS_BAR), bst);
#define TIDS() const int tid = otid(), lane = tid & 63, wid = __builtin_amdgcn_readfirstlane(tid >> 6), gw = bid * 8 + wid, gtid = bid * 512 + tid; (void)lane; (void)gw; (void)gtid; LAS float* scr = (LAS float*)(lds + wid * 8448); (void)scr
#define PTRS() unsigned char* ws = P.ws; asm volatile("" : "+s"(ws)); float* X = P.out; asm volatile("" : "+s"(X)); \
    float* kms = (float*)(ws + WS_KMS); float* cosT = (float*)(ws + WS_COS); float* sinT = (float*)(ws + WS_SIN); \
    bf16* H = (bf16*)(ws + WS_H); bf16* Qb = (bf16*)(ws + WS_Q); bf16* Kb = (bf16*)(ws + WS_K); bf16* Vb = (bf16*)(ws + WS_V); bf16* Ob = (bf16*)(ws + WS_O); \
    bf16* U = (bf16*)(ws + WS_U); bf16* A = (bf16*)(ws + WS_A); \
    (void)kms; (void)cosT; (void)sinT; (void)H; (void)Qb; (void)Kb; (void)Vb; (void)Ob; (void)U; (void)A; (void)X

    { TIDS(); PTRS();
    for (int idx = gtid; idx < S * 32; idx += NTH) {
        const int pos = idx >> 5, i = idx & 31;
        const float inv = 1.0f / powf(10000.0f, (float)(2 * i) / 64.0f);
        const float ang = (float)pos * inv;
        cosT[idx] = cosf(ang); sinT[idx] = sinf(ang);
    }
    for (int idx = gtid; idx < 2 * 64 * 256; idx += NTH) kms[idx] = 0.f;
    for (int idx = gtid; idx < S * D / 8; idx += NTH) {
        const f32x4 a = *((const f32x4*)P.in[0] + 2 * (size_t)idx), b = *((const f32x4*)P.in[0] + 2 * (size_t)idx + 1);
        u32x4 w; w.x = cvtpk(a[0], a[1]); w.y = cvtpk(a[2], a[3]); w.z = cvtpk(b[0], b[1]); w.w = cvtpk(b[2], b[3]);
        *((u32x4*)H + idx) = w;
    }
    for (int it = gw; it < WI_ALL; it += NGW) wconv_layer_item(P, 0, it, scr, lane);
    }
    grid.sync();

#ifndef XSYNC
#define XSYNC 0
#endif
#pragma unroll 1
    for (int L = 0; L < DEPTH; ++L) {
        const int ev = !(L & 1);
        for (int xs_ = 0; xs_ < XSYNC; ++xs_) xcd_barrier(bar);
        {   PTRS(); unsigned char* wb = ws + ((L & 1) ? WS_W1 : WS_W0);
            pg8::Gemm g{H, (const bf16*)(wb + WO_QKV), S, 3072, D}; pg8::StaticOrder SO; SO.init(S, 3072, G, bid);
            EpiQKV E{Qb, cosT, sinT, kms + (size_t)(L >> 1) * 64 * 256, ev};
            GEMMCALL1 pg8::gemm_phase<EpiQKV, pg8::StaticOrder, true, true>(lds, g, SO, E);
        }
        xcd_barrier(bar);
#ifndef ATT_REP_E
#define ATT_REP_E 1
#endif
#ifndef ATT_REP_O
#define ATT_REP_O 1
#endif
        for (int rep_ = 0; rep_ < (ev ? ATT_REP_E : ATT_REP_O); ++rep_)
        {   PTRS();
        if (ev) {
            const float* kl = kms + (size_t)(L >> 1) * 64 * 256;
            for (int it = bid; it < 640; it += G) {
                if (it < 256) { MOBA2(it & 3, it >> 2); }
                else { const int uidx = it - 256; DIL1(4 + uidx % 12, uidx / 12); }
            }
        } else {
            for (int it = bid; it < 512; it += G) SB1(it & 7, it >> 3);
        }
        }
        xcd_barrier(bar);
        {   PTRS(); unsigned char* wb = ws + ((L & 1) ? WS_W1 : WS_W0);
            pg8::Gemm g{Ob, (const bf16*)(wb + WO_O), S, D, D}; pg8::StaticOrder SO; SO.init(S, D, G, bid);
            EpiResid E{(L == 0) ? P.in[0] : X, X};
            GEMMCALL2 pg8::gemm_phase<EpiResid, pg8::StaticOrder, true, true>(lds, g, SO, E);
        }
        xcd_barrier(bar);
        { TIDS(); PTRS(); for (int row = gw; row < S; row += NGW) ln_row(X + (size_t)row * D, H + (size_t)row * D, P.in[5] + L * D, P.in[6] + L * D, lane); }
        xcd_barrier(bar);
        {   PTRS(); unsigned char* wb = ws + ((L & 1) ? WS_W1 : WS_W0);
            pg8::Gemm g{H, (const bf16*)(wb + WO_UP), S, F2, D}; pg8::StaticOrder SO; SO.init(S, F2, G, bid);
            pg8::EpiBf16<0> E{U, F2, nullptr, 0, 0, 1.f};
            GEMMCALL3 pg8::gemm_phase<pg8::EpiBf16<0>, pg8::StaticOrder, true, true>(lds, g, SO, E);
        }
        xcd_barrier(bar);
        {
            TIDS(); PTRS(); const int nconv = 512 * 11, ntot = nconv + (L + 1 < DEPTH ? WI_ALL : 0);
            for (int it = gw; it < ntot; it += NGW) {
                if (it < nconv) conv_item(U, A, P.in[8] + (size_t)L * 3 * F2, P.in[9] + (size_t)L * F2, it, lane);
                else wconv_layer_item(P, L + 1, it - nconv, scr, lane);
            }
        }
        xcd_barrier(bar);
        {   PTRS(); unsigned char* wb = ws + ((L & 1) ? WS_W1 : WS_W0);
            pg8::Gemm g{A, (const bf16*)(wb + WO_DN), S, D, F}; pg8::StaticOrder SO; SO.init(S, D, G, bid);
            EpiResid E{X, X};
            GEMMCALL4 pg8::gemm_phase<EpiResid, pg8::StaticOrder, true, true>(lds, g, SO, E);
        }
        xcd_barrier(bar);
        { TIDS(); PTRS(); for (int row = gw; row < S; row += NGW) ln_row(X + (size_t)row * D, H + (size_t)row * D, P.in[11] + L * D, P.in[12] + L * D, lane); }
        xcd_barrier(bar);
    }
}

extern "C" void kernel_launch(void* const* d_in, const int* in_sizes, int n_in, void* d_out, int out_size, void* d_ws, size_t ws_size, hipStream_t stream) {
    static int grid = 0;
    if (grid == 0) {
        if (n_in != 13 || in_sizes[0] != S * D || out_size != S * D || ws_size < WS_END) {
            fprintf(stderr, "kernel_launch: unexpected shapes (n_in %d, in0 %d, out %d, ws %zu < %zu)\n", n_in, n_in > 0 ? in_sizes[0] : -1, out_size, ws_size, (size_t)WS_END); grid = -1; return; }
        int dev = 0, cus = 0, per_cu = 0;
        hipGetDevice(&dev); hipDeviceGetAttribute(&cus, hipDeviceAttributeMultiprocessorCount, dev);
        if (hipFuncSetAttribute((const void*)mega_fwd, hipFuncAttributeMaxDynamicSharedMemorySize, LDS_BYTES) != hipSuccess) { fprintf(stderr, "kernel_launch: hipFuncSetAttribute failed\n"); grid = -1; return; }
        if (hipOccupancyMaxActiveBlocksPerMultiprocessor(&per_cu, (const void*)mega_fwd, 512, LDS_BYTES) != hipSuccess || per_cu < 1) { fprintf(stderr, "kernel_launch: occupancy query says %d\n", per_cu); per_cu = 1; }
        (void)hipGetLastError();
        grid = cus * 1;
    }
    if (grid < 0) return;
    if (hipMemsetAsync((char*)d_ws + WS_BAR, 0, 16384, stream) != hipSuccess) { fprintf(stderr, "kernel_launch: memset failed\n"); return; }
    Params p{};
    for (int i = 0; i < 13; ++i) p.in[i] = (const float*)d_in[i];
    p.out = (float*)d_out; p.ws = (unsigned char*)d_ws;
    void* args[] = {&p};
    hipError_t e = hipLaunchCooperativeKernel((const void*)mega_fwd, dim3(grid), dim3(512), args, LDS_BYTES, stream);
    if (e != hipSuccess) fprintf(stderr, "cooperative launch failed: %s (grid %d)\n", hipGetErrorString(e), grid);
}
```
